# Optimizing an MI355X kernel written in HIP

```python
import jax
import jax.numpy as jnp
from jax import lax
import numpy as np


D_MODEL = 2048
BATCH = 8
SEQ = 2048
DEPTH = 2

MEM_LEN = 256
D_FF = 5632
EPS = 1e-6
N_BRANCH = 3

SGU_GROUPS = 4
SGU_GROUP_DIM = D_MODEL // 8
SGU_WIDTH = SGU_GROUPS * SGU_GROUP_DIM
SGU_CHUNK = 128

FOX_HEADS = 8
FOX_HEAD_DIM = D_MODEL // 16
FOX_WIDTH = FOX_HEADS * FOX_HEAD_DIM
FOX_BLOCK = 128

GLA_HEADS = 4
GLA_DK = D_MODEL // 16
GLA_DV = D_MODEL // 8
GLA_KW = GLA_HEADS * GLA_DK
GLA_VW = GLA_HEADS * GLA_DV
GLA_GATE_RANK = 16
GLA_GATE_TAU = 16.0
GLA_CHUNK = 64

XA_HEADS = 4
XA_HEAD_DIM = D_MODEL // 16
XA_WIDTH = XA_HEADS * XA_HEAD_DIM

N_IN = (2 * SGU_WIDTH + 3 * FOX_WIDTH + FOX_HEADS + 2 * GLA_KW + GLA_VW
        + GLA_GATE_RANK + GLA_VW + N_BRANCH * D_MODEL)

kernel_name = 'hybrid_sgu_fox_gla_macaron_block'


def _in_widths():
    return (SGU_WIDTH, SGU_WIDTH,
            FOX_WIDTH, FOX_WIDTH, FOX_WIDTH, FOX_HEADS,
            GLA_KW, GLA_KW, GLA_VW, GLA_GATE_RANK,
            GLA_VW,
            N_BRANCH * D_MODEL)


def _split_cols(z, widths):
    idx = [int(i) for i in np.cumsum(widths)[:-1]]
    return jnp.split(z, idx, axis=-1)


def rms_norm(x, g):
    xf = x.astype(jnp.float32)
    y = xf * lax.rsqrt(jnp.mean(xf * xf, axis=-1, keepdims=True) + EPS)
    return (y * g.astype(jnp.float32)).astype(x.dtype)


def layer_norm(x, g, b):
    xf = x.astype(jnp.float32)
    mu = jnp.mean(xf, axis=-1, keepdims=True)
    xc = xf - mu
    var = jnp.mean(xc * xc, axis=-1, keepdims=True)
    y = xc * lax.rsqrt(var + EPS) * g.astype(jnp.float32) + b.astype(jnp.float32)
    return y.astype(x.dtype)


def swiglu_ffn(x, w_in, w_out):
    gate, up = jnp.split(x @ w_in, 2, axis=-1)
    return (jax.nn.silu(gate) * up) @ w_out


def sgu_branch(u, v, ln_g, ln_b, w_s, b_s):
    B, S, _ = u.shape
    n_chunks = S // SGU_CHUNK
    u = jax.nn.gelu(u)
    v = jax.nn.gelu(v)
    v = layer_norm(v.reshape(B, S, SGU_GROUPS, SGU_GROUP_DIM), ln_g, ln_b)
    v = v.reshape(B, n_chunks, SGU_CHUNK, SGU_GROUPS, SGU_GROUP_DIM)
    causal = jnp.tril(jnp.ones((SGU_CHUNK, SGU_CHUNK), dtype=bool))
    w = jnp.where(causal[None], w_s, jnp.zeros_like(w_s))
    mixed = jnp.einsum('gts,bnsgc->bntgc', w, v) + jnp.swapaxes(b_s, 0, 1)[:, :, None]
    return u * mixed.reshape(B, S, SGU_WIDTH)


def fox_branch(q, k, v, f_logit, b_f):
    B, S, _ = q.shape
    H, Dh = FOX_HEADS, FOX_HEAD_DIM
    q = q.reshape(B, S, H, Dh).transpose(0, 2, 1, 3) * (Dh ** -0.5)
    k = k.reshape(B, S, H, Dh).transpose(0, 2, 1, 3)
    v = v.reshape(B, S, H, Dh).transpose(0, 2, 1, 3)
    log_f = jax.nn.log_sigmoid((f_logit + b_f).astype(jnp.float32))
    cum = jnp.cumsum(log_f, axis=1).transpose(0, 2, 1)
    outs = []
    for i in range(S // FOX_BLOCK):
        lo = i * FOX_BLOCK
        hi = lo + FOX_BLOCK
        logits = jnp.einsum('bhtd,bhsd->bhts', q[:, :, lo:hi], k[:, :, :hi]).astype(jnp.float32)
        logits = logits + cum[:, :, lo:hi, None] - cum[:, :, None, :hi]
        causal = (lo + jnp.arange(FOX_BLOCK))[:, None] >= jnp.arange(hi)[None, :]
        logits = jnp.where(causal, logits, -jnp.inf)
        p = jax.nn.softmax(logits, axis=-1).astype(v.dtype)
        outs.append(jnp.einsum('bhts,bhsd->bhtd', p, v[:, :, :hi]))
    o = jnp.concatenate(outs, axis=2)
    return o.transpose(0, 2, 1, 3).reshape(B, S, FOX_WIDTH)


def gla_branch(q, k, v, a_low, r, w_gate, b_gate, o_norm):
    B, S, _ = q.shape
    H, dk, dv, C = GLA_HEADS, GLA_DK, GLA_DV, GLA_CHUNK
    n = S // C
    dt = v.dtype
    f32 = jnp.float32
    g = jax.nn.log_sigmoid((a_low @ w_gate + b_gate).astype(f32)) / GLA_GATE_TAU

    def chunks(t, d):
        return t.astype(f32).reshape(B, n, C, H, d).transpose(0, 1, 3, 2, 4)

    qc = chunks(q, dk) * (dk ** -0.5)
    kc = chunks(k, dk)
    vc = chunks(v, dv)
    bc = jnp.cumsum(chunks(g, dk), axis=3)
    b_last = bc[:, :, :, -1:, :]
    b_ref = bc[:, :, :, C // 2:C // 2 + 1, :]
    causal = jnp.tril(jnp.ones((C, C), dtype=bool))
    att = jnp.einsum('bnhtd,bnhsd->bnhts', qc * jnp.exp(bc - b_ref), kc * jnp.exp(b_ref - bc))
    att = jnp.where(causal, att, 0.0)
    o_intra = jnp.einsum('bnhts,bnhsv->bnhtv', att, vc)
    upd = jnp.einsum('bnhsd,bnhsv->bnhdv', kc * jnp.exp(b_last - bc), vc)
    decay = jnp.swapaxes(jnp.exp(b_last), -1, -2)

    def step(state, inp):
        dec, u_n = inp
        return dec * state + u_n, state

    init = jnp.zeros((B, H, dk, dv), f32)
    _, s_prev = lax.scan(step, init, (jnp.moveaxis(decay, 1, 0), jnp.moveaxis(upd, 1, 0)))
    s_prev = jnp.moveaxis(s_prev, 0, 1)
    o_inter = jnp.einsum('bnhtd,bnhdv->bnhtv', qc * jnp.exp(bc), s_prev)
    o = (o_intra + o_inter).transpose(0, 1, 3, 2, 4).reshape(B, S, H, dv)
    o = rms_norm(o, o_norm).reshape(B, S, GLA_VW).astype(dt)
    return o * jax.nn.silu(r)


def cross_attention(n, m, w_q, w_kv, w_o):
    B, S, _ = n.shape
    M = m.shape[1]
    q = (n @ w_q).reshape(B, S, XA_HEADS, XA_HEAD_DIM) * (XA_HEAD_DIM ** -0.5)
    k, v = jnp.split(m @ w_kv, 2, axis=-1)
    k = k.reshape(B, M, XA_HEADS, XA_HEAD_DIM)
    v = v.reshape(B, M, XA_HEADS, XA_HEAD_DIM)
    logits = jnp.einsum('bthd,bmhd->bhtm', q, k).astype(jnp.float32)
    p = jax.nn.softmax(logits, axis=-1).astype(v.dtype)
    o = jnp.einsum('bhtm,bmhd->bthd', p, v).reshape(B, S, XA_WIDTH)
    return o @ w_o


def setup_inputs(seed: int = 0) -> dict:
    key = jax.random.key(seed)
    ks = iter(jax.random.split(key, 48))
    L, D = DEPTH, D_MODEL

    def nrm(shape, scale):
        return scale * jax.random.normal(next(ks), shape, jnp.float32)

    def gain(shape):
        return 1.0 + 0.02 * jax.random.normal(next(ks), shape, jnp.float32)

    return {
        'x': nrm((BATCH, SEQ, D), 1.0),
        'mem': nrm((BATCH, MEM_LEN, D), 1.0),
        'ffn1_norm': gain((L, D)),
        'ffn1_w_in': nrm((L, D, 2 * D_FF), D ** -0.5),
        'ffn1_w_out': nrm((L, D_FF, D), D_FF ** -0.5),
        'mix_norm': gain((L, D)),
        'w_in': nrm((L, D, N_IN), D ** -0.5),
        'sgu_ln_g': gain((L, SGU_GROUPS, SGU_GROUP_DIM)),
        'sgu_ln_b': nrm((L, SGU_GROUPS, SGU_GROUP_DIM), 0.02),
        'sgu_w_s': nrm((L, SGU_GROUPS, SGU_CHUNK, SGU_CHUNK), SGU_CHUNK ** -0.5),
        'sgu_b_s': gain((L, SGU_GROUPS, SGU_CHUNK)),
        'fox_b_f': 2.0 + nrm((L, FOX_HEADS), 0.5),
        'gla_w_gate': nrm((L, GLA_GATE_RANK, GLA_KW), GLA_GATE_RANK ** -0.5),
        'gla_b_gate': nrm((L, GLA_KW), 0.01),
        'gla_o_norm': gain((L, GLA_HEADS, GLA_DV)),
        'w_branch_a': nrm((L, SGU_WIDTH, D), SGU_WIDTH ** -0.5),
        'w_branch_b': nrm((L, FOX_WIDTH, D), FOX_WIDTH ** -0.5),
        'w_branch_c': nrm((L, GLA_VW, D), GLA_VW ** -0.5),
        'w_out': nrm((L, D, D), D ** -0.5),
        'xa_norm': gain((L, D)),
        'mem_norm': gain((L, D)),
        'xa_w_q': nrm((L, D, XA_WIDTH), D ** -0.5),
        'xa_w_kv': nrm((L, D, 2 * XA_WIDTH), D ** -0.5),
        'xa_w_o': nrm((L, XA_WIDTH, D), XA_WIDTH ** -0.5),
        'ffn2_norm': gain((L, D)),
        'ffn2_w_in': nrm((L, D, 2 * D_FF), D ** -0.5),
        'ffn2_w_out': nrm((L, D_FF, D), D_FF ** -0.5),
        'final_norm': gain((D,)),
    }


def reference(x, mem, ffn1_norm, ffn1_w_in, ffn1_w_out, mix_norm, w_in,
              sgu_ln_g, sgu_ln_b, sgu_w_s, sgu_b_s, fox_b_f,
              gla_w_gate, gla_b_gate, gla_o_norm,
              w_branch_a, w_branch_b, w_branch_c, w_out,
              xa_norm, mem_norm, xa_w_q, xa_w_kv, xa_w_o,
              ffn2_norm, ffn2_w_in, ffn2_w_out, final_norm):
    h = x
    for l in range(DEPTH):
        h = h + 0.5 * swiglu_ffn(rms_norm(h, ffn1_norm[l]), ffn1_w_in[l], ffn1_w_out[l])

        n = rms_norm(h, mix_norm[l])
        (su, sv, fq, fk, fv, ff, gq, gk, gv, ga, gr, gates) = _split_cols(n @ w_in[l], _in_widths())
        y_a = sgu_branch(su, sv, sgu_ln_g[l], sgu_ln_b[l], sgu_w_s[l], sgu_b_s[l]) @ w_branch_a[l]
        y_b = fox_branch(fq, fk, fv, ff, fox_b_f[l]) @ w_branch_b[l]
        y_c = gla_branch(gq, gk, gv, ga, gr, gla_w_gate[l], gla_b_gate[l], gla_o_norm[l]) @ w_branch_c[l]
        g_a, g_b, g_c = jnp.split(jax.nn.sigmoid(gates), N_BRANCH, axis=-1)
        h = h + (g_a * y_a + g_b * y_b + g_c * y_c) @ w_out[l]

        h = h + cross_attention(rms_norm(h, xa_norm[l]), rms_norm(mem, mem_norm[l]),
                                xa_w_q[l], xa_w_kv[l], xa_w_o[l])

        h = h + 0.5 * swiglu_ffn(rms_norm(h, ffn2_norm[l]), ffn2_w_in[l], ffn2_w_out[l])
    return rms_norm(h, final_norm)
```

```cpp
#include <hip/hip_runtime.h>
#include <hip/hip_cooperative_groups.h>
#include <cstdio>
#include <cstdint>
namespace cg = cooperative_groups;

#ifndef MK_LAUNCHES
#define MK_LAUNCHES 1
#endif

#define LAS __attribute__((address_space(3)))
typedef unsigned short bf16_t;
typedef short bf16x8 __attribute__((ext_vector_type(8)));
typedef float f32x4 __attribute__((ext_vector_type(4)));
typedef unsigned u32x4 __attribute__((ext_vector_type(4)));
typedef unsigned u32x2 __attribute__((ext_vector_type(2)));

constexpr int T = 16384, D = 2048, DFF = 5632, SEQ = 2048, NB = 8, MEMT = 2048  ;
constexpr int NINP = 14592;
constexpr float EPS = 1e-6f;
constexpr float LOG2E = 1.4426950408889634f, LN2 = 0.6931471805599453f;
constexpr int NTHREADS = 512;
constexpr int LDS_BYTES = 133120;
constexpr int MISC_OFF = 131072;

constexpr size_t SZ_FFN_IN = (size_t)2 * DFF * D * 2, SZ_FFN_OUT = (size_t)D * DFF * 2, SZ_WIN = (size_t)NINP * D * 2, SZ_BR = (size_t)D * 1024 * 2, SZ_WOUT = (size_t)D * D * 2;
constexpr size_t SZ_XQ = (size_t)512 * D * 2, SZ_XKV = (size_t)1024 * D * 2, SZ_XO = (size_t)D * 512 * 2;
constexpr size_t W_FFN1_IN = 0, W_FFN1_OUT = W_FFN1_IN + SZ_FFN_IN, W_IN = W_FFN1_OUT + SZ_FFN_OUT, W_BA = W_IN + SZ_WIN, W_BB = W_BA + SZ_BR, W_BC = W_BB + SZ_BR,
                 W_OUT = W_BC + SZ_BR, W_XQ = W_OUT + SZ_WOUT, W_XKV = W_XQ + SZ_XQ, W_XO = W_XKV + SZ_XKV, W_FFN2_IN = W_XO + SZ_XO, W_FFN2_OUT = W_FFN2_IN + SZ_FFN_IN,
                 W_END = W_FFN2_OUT + SZ_FFN_OUT;
constexpr size_t WS_CTL = W_END;
constexpr size_t CTL_BAR = 4096;
constexpr size_t CTL_SSQ = 4096 + 16384;
constexpr size_t CTL_BYTES = CTL_SSQ + (size_t)9 * T * 8;
constexpr size_t WS_SSQM = WS_CTL + CTL_BYTES;
constexpr size_t WS_HB = WS_SSQM + 16384;
constexpr size_t WS_MB = WS_HB + (size_t)T * D * 2;
constexpr size_t WS_MEMB = WS_MB + (size_t)T * D * 2;
constexpr size_t WS_KV = WS_MEMB + (size_t)MEMT * D * 2;
constexpr size_t WS_LOGF = WS_KV + (size_t)MEMT * 1024 * 2;
constexpr size_t WS_GA = WS_LOGF + (size_t)T * 8 * 4;
constexpr size_t WS_Z = WS_GA + (size_t)T * 16 * 4;
constexpr size_t Z_U = WS_Z, Z_FQ = Z_U + (size_t)T * 1024 * 2, Z_GR = Z_FQ + (size_t)T * 1024 * 2, Z_GATES = Z_GR + (size_t)T * 1024 * 2,
                 Z_V = Z_GATES + (size_t)T * 6144 * 2, Z_FK = Z_V + (size_t)T * 1024 * 2, Z_FV = Z_FK + (size_t)T * 1024 * 2, Z_GQ = Z_FV + (size_t)T * 1024 * 2,
                 Z_GK = Z_GQ + (size_t)T * 512 * 2, Z_GV = Z_GK + (size_t)T * 512 * 2, Z_END = Z_GV + (size_t)T * 1024 * 2;
constexpr size_t WS_MA = Z_GQ;
constexpr size_t WS_ACT = WS_Z;
constexpr size_t WS_XQB = WS_Z, WS_XOB = WS_Z + (size_t)T * 512 * 2;
constexpr size_t WS_OI = WS_MB;
constexpr size_t WS_UC = Z_END;
constexpr size_t WS_M32 = WS_UC;
constexpr size_t WS_QDF = WS_UC + (size_t)1024 * 32768 * 4;
constexpr size_t WS_DEC = WS_QDF + (size_t)1024 * 8192 * 2;
constexpr size_t WS_END = WS_DEC + (size_t)1024 * 128 * 4;
static_assert(WS_MA + (size_t)T * D * 2 <= Z_END && WS_ACT + (size_t)T * DFF * 2 <= Z_END, "aliases fit");
static_assert(WS_CTL % 256 == 0 && WS_HB % 256 == 0 && WS_Z % 256 == 0, "alignment");

typedef float f32x2_t __attribute__((ext_vector_type(2)));
typedef __bf16 bf16x2_t __attribute__((ext_vector_type(2)));
__device__ __forceinline__ unsigned cvt_pk_bf16(float lo, float hi) { const f32x2_t v = {lo, hi}; const bf16x2_t b = __builtin_convertvector(v, bf16x2_t); return __builtin_bit_cast(unsigned, b); }
__device__ __forceinline__ float bflo(unsigned u) { return __builtin_bit_cast(float, u << 16); }
__device__ __forceinline__ float bfhi(unsigned u) { return __builtin_bit_cast(float, u & 0xffff0000u); }
__device__ __forceinline__ float bf2f(bf16_t b) { return __builtin_bit_cast(float, ((unsigned)b) << 16); }
__device__ __forceinline__ bf16_t f2bf(float f) { return (bf16_t)(cvt_pk_bf16(f, 0.f) & 0xffffu); }
__device__ __forceinline__ float fexp2(float x) { return __builtin_amdgcn_exp2f(x); }
__device__ __forceinline__ float flog2(float x) { return __builtin_amdgcn_logf(x); }
__device__ __forceinline__ float frcp(float x) { return __builtin_amdgcn_rcpf(x); }
__device__ __forceinline__ float frsq(float x) { return __builtin_amdgcn_rsqf(x); }
__device__ __forceinline__ float sigmoidf_(float x) { return frcp(1.f + fexp2(-x * LOG2E)); }
__device__ __forceinline__ float siluf_(float x) { return x * sigmoidf_(x); }
__device__ __forceinline__ float gelu_tanh(float x) { const float u = x + 0.044715f * x * x * x; return x * frcp(1.f + fexp2(-2.3022082f * u)); }
__device__ __forceinline__ float logsigmoidf_(float x) { return fminf(x, 0.f) - LN2 * flog2(1.f + fexp2(-fabsf(x) * LOG2E)); }
typedef float f32x2 __attribute__((ext_vector_type(2)));
__device__ __forceinline__ f32x2 exp2_2(f32x2 t) { f32x2 e; e.x = fexp2(t.x); e.y = fexp2(t.y); return e; }
__device__ __forceinline__ f32x2 rcp_2(f32x2 d) { f32x2 r; r.x = frcp(d.x); r.y = frcp(d.y); return r; }
__device__ __forceinline__ f32x2 swiglu2(f32x2 g, f32x2 u, float na, float rs2) { const f32x2 r = rcp_2(exp2_2(g * na) + 1.0f); return (g * u) * (r * rs2); }
__device__ __forceinline__ f32x2 sigmoid2(f32x2 x, float na) { return rcp_2(exp2_2(x * na) + 1.0f); }
__device__ __forceinline__ f32x2 gelu2(f32x2 x, float rs) { const f32x2 v = x * rs; const f32x2 w = v * (v * v * 0.044715f + 1.0f); return v * rcp_2(exp2_2(w * -2.3022082f) + 1.0f); }
typedef unsigned long long u64;
__device__ __forceinline__ float rstd_of(u64 ssq) { return frsq((float)ssq * (1.0f / (2048.0f * 16777216.0f)) + EPS); }
__device__ __forceinline__ u64 ssq_fix(float s) { return (u64)__float2ull_rn(s * 16777216.0f); }

namespace pg8 {
constexpr int BM = 256, BK = 64, HALF = 128, HTB = HALF * BK * 2, STAGE_BYTES = 8 * HTB, NXCD = 8, WGM = 8;
__host__ __device__ __forceinline__ int lds_byte(int r, int c) { const int st = (r >> 4) * 2 + (c >> 5), rr = r & 15, cc = c & 31, ob = rr * 64 + cc * 2; return st * 1024 + (ob ^ (((ob >> 9) & 1) << 5)); }
__host__ __device__ __forceinline__ void stage_rc(int b, int& R, int& C) { const int st = b / 1024, sb = b % 1024, swz = sb ^ (((sb >> 9) & 1) << 5); R = (st >> 1) * 16 + swz / 64; C = (st & 1) * 32 + (swz % 64) / 2; }
__host__ __device__ __forceinline__ int perm32(int rho) { const int n = rho >> 4, i = rho & 15; return 8 * (i >> 2) + 4 * n + (i & 3); }

struct Unit { int pm, pn; };
struct Gemm { const bf16_t* A; const bf16_t* Bt; int M, N, K; };

struct StaticOrder {
    int nM, nN, nwg, G, c;
    __device__ void init(int M, int N, int G_, int c_) { nM = M / BM; nN = N / BM; nwg = nM * nN; G = G_; c = c_; }
    __device__ bool next(int i, Unit& u) const {
        const long L = (long)i * G + c; if (L >= nwg) return false;
        int wgid = (int)L; { const int q = nwg / NXCD, r = nwg % NXCD, xcd = wgid % NXCD, off = wgid / NXCD; wgid = (xcd < r ? xcd * (q + 1) : r * (q + 1) + (xcd - r) * q) + off; }
        const int nig = WGM * nN, gid = wgid / nig, fm = gid * WGM, gsz = (nM - fm) < WGM ? (nM - fm) : WGM;
        u.pm = fm + ((wgid % nig) % gsz); u.pn = (wgid % nig) / gsz; return true;
    }
};

template <class Epi, class Sched, bool ALIGN_EPI = true, bool SP2 = true>
__device__ __forceinline__ void gemm_phase(LAS unsigned char* lds, const Gemm g, const Sched& S, const Epi& E) {
    int tid_ = threadIdx.x; asm volatile("" : "+v"(tid_));
    const int tid = tid_, wid = __builtin_amdgcn_readfirstlane(tid >> 6), lane = tid & 63, wr = wid >> 2, wc = wid & 3, fr = lane & 15, fq = lane >> 4;
    const int K = g.K, nt = K / BK;
    unsigned voffA[2], voffB[2];
#pragma unroll
    for (int i = 0; i < 2; ++i) { int R, C; stage_rc(tid * 16 + i * 8192, R, C); const int Rb = (R & ~31) + perm32(R & 31);
        voffA[i] = (unsigned)(R * K + C) * 2u; voffB[i] = (unsigned)(Rb * K + C) * 2u; }
    const size_t kstep = (size_t)(BK * 2);
    const size_t hstep = (size_t)HALF * K * 2;
    const size_t tstep = 2 * hstep;
    const unsigned ldsw = (unsigned)wid * 1024u;
    const int aoff = lds_byte(wr * 64 + fr, fq * 8), boff = lds_byte(wc * 32 + fr, fq * 8);
#define PG8_SA(b, h) (((b) * 2 + (h)) * HTB)
#define PG8_SB(b, h) ((4 + (b) * 2 + (h)) * HTB)
#define PG8_STAGE(bufoff, gbase, voff) do { _Pragma("unroll") for (int _i = 0; _i < 2; ++_i) \
        __builtin_amdgcn_global_load_lds((const unsigned*)((const char*)(gbase) + (voff)[_i]), (LAS unsigned*)(lds + (bufoff) + ldsw + _i * 8192), 16, 0, 0); } while (0)
#define PG8_LDA(dst, b, h) do { _Pragma("unroll") for (int m = 0; m < 4; ++m) _Pragma("unroll") for (int k = 0; k < 2; ++k) dst[m][k] = *(const LAS bf16x8*)(lds + PG8_SA(b, h) + aoff + m * 2048 + k * 1024); } while (0)
#define PG8_LDB(dst, b, h) do { _Pragma("unroll") for (int n = 0; n < 2; ++n) _Pragma("unroll") for (int k = 0; k < 2; ++k) dst[n][k] = *(const LAS bf16x8*)(lds + PG8_SB(b, h) + boff + n * 2048 + k * 1024); } while (0)
#define PG8_MMA(ai, bj, At, Bt) do { __builtin_amdgcn_s_setprio(1); _Pragma("unroll") for (int m = 0; m < 4; ++m) _Pragma("unroll") for (int n = 0; n < 2; ++n) _Pragma("unroll") for (int k = 0; k < 2; ++k) \
        acc[ai][bj][m][n] = __builtin_amdgcn_mfma_f32_16x16x32_bf16(Bt[n][k], At[m][k], acc[ai][bj][m][n], 0, 0, 0); __builtin_amdgcn_s_setprio(0); } while (0)
#define PG8_WAIT_V(n) asm volatile("s_waitcnt vmcnt(" #n ")" ::: "memory")
#define PG8_WAIT_L(n) asm volatile("s_waitcnt lgkmcnt(" #n ")" ::: "memory")
#define PG8_BAR __builtin_amdgcn_s_barrier()
#define PG8_SCHED __builtin_amdgcn_sched_barrier(0)
    Unit cur, nxt; int ui = 0;
    if (!S.next(0, cur)) return;
    f32x4 acc[2][2][4][2];
#pragma unroll
    for (int a = 0; a < 2; ++a)
#pragma unroll
        for (int b = 0; b < 2; ++b)
#pragma unroll
            for (int m = 0; m < 4; ++m)
#pragma unroll
                for (int n = 0; n < 2; ++n) acc[a][b][m][n] = (f32x4){0.f, 0.f, 0.f, 0.f};
    bf16x8 At[4][2], B0[2][2], B1[2][2];
    const char* cA = (const char*)g.A + (size_t)cur.pm * tstep; const char* cB = (const char*)g.Bt + (size_t)cur.pn * tstep;
    if constexpr (SP2) {
        PG8_STAGE(PG8_SB(0, 0), cB, voffB); PG8_STAGE(PG8_SB(0, 1), cB + hstep, voffB); PG8_STAGE(PG8_SA(0, 0), cA, voffA); PG8_STAGE(PG8_SA(0, 1), cA + hstep, voffA);
        if (wr == 1) PG8_BAR;
        PG8_WAIT_V(2); PG8_BAR;
        PG8_STAGE(PG8_SB(1, 0), cB + kstep, voffB); PG8_STAGE(PG8_SA(1, 0), cA + kstep, voffA); PG8_STAGE(PG8_SB(1, 1), cB + hstep + kstep, voffB);
        PG8_WAIT_V(6); PG8_BAR;
    } else {
        PG8_STAGE(PG8_SB(0, 0), cB, voffB); PG8_STAGE(PG8_SA(0, 0), cA, voffA); PG8_STAGE(PG8_SB(0, 1), cB + hstep, voffB); PG8_STAGE(PG8_SA(0, 1), cA + hstep, voffA);
        if (wr == 1) PG8_BAR;
        PG8_WAIT_V(4); PG8_BAR;
        PG8_STAGE(PG8_SB(1, 0), cB + kstep, voffB); PG8_STAGE(PG8_SA(1, 0), cA + kstep, voffA); PG8_STAGE(PG8_SB(1, 1), cB + hstep + kstep, voffB);
        PG8_WAIT_V(6); PG8_BAR;
    }
    for (;;) {
        const bool has_next = S.next(ui + 1, nxt);
        const char* nA = has_next ? (const char*)g.A + (size_t)nxt.pm * tstep : cA; const char* nB = has_next ? (const char*)g.Bt + (size_t)nxt.pn * tstep : cB;
        for (int t = 0; t < nt; t += 2) {
            const bool last = (t == nt - 2);
            const char* a1 = cA + (size_t)(t + 1) * kstep;
            const char* a2 = last ? nA : cA + (size_t)(t + 2) * kstep; const char* b2 = last ? nB : cB + (size_t)(t + 2) * kstep;
            const char* a3 = a2 + kstep; const char* b3 = b2 + kstep;
            if constexpr (SP2) {
            PG8_LDB(B0, 0, 0); PG8_LDB(B1, 0, 1); PG8_SCHED; PG8_LDA(At, 0, 0); PG8_STAGE(PG8_SA(1, 1), a1 + hstep, voffA);
            PG8_WAIT_V(8); PG8_WAIT_L(0); PG8_BAR; PG8_MMA(0, 0, At, B0); PG8_MMA(0, 1, At, B1); PG8_BAR; PG8_SCHED;
            PG8_LDA(At, 0, 1); PG8_STAGE(PG8_SB(0, 0), b2, voffB); PG8_STAGE(PG8_SB(0, 1), b2 + hstep, voffB); PG8_STAGE(PG8_SA(0, 0), a2, voffA);
            PG8_WAIT_V(8); PG8_WAIT_L(0); PG8_BAR; PG8_MMA(1, 0, At, B0); PG8_MMA(1, 1, At, B1); PG8_BAR; PG8_SCHED;
            PG8_LDB(B0, 1, 0); PG8_LDB(B1, 1, 1); PG8_SCHED; PG8_LDA(At, 1, 0); PG8_STAGE(PG8_SA(0, 1), a2 + hstep, voffA);
            PG8_WAIT_V(8); PG8_WAIT_L(0); PG8_BAR; PG8_MMA(0, 0, At, B0); PG8_MMA(0, 1, At, B1); PG8_BAR; PG8_SCHED;
            PG8_LDA(At, 1, 1); PG8_STAGE(PG8_SB(1, 0), b3, voffB); PG8_STAGE(PG8_SB(1, 1), b3 + hstep, voffB); PG8_STAGE(PG8_SA(1, 0), a3, voffA);
            PG8_WAIT_V(8); PG8_WAIT_L(0); PG8_BAR; PG8_MMA(1, 0, At, B0); PG8_MMA(1, 1, At, B1); PG8_BAR; PG8_SCHED;
            } else {
            PG8_LDB(B0, 0, 0); PG8_SCHED; PG8_LDA(At, 0, 0); PG8_STAGE(PG8_SA(1, 1), a1 + hstep, voffA);
            PG8_WAIT_L(8); PG8_BAR; PG8_WAIT_L(0); PG8_MMA(0, 0, At, B0); PG8_BAR; PG8_SCHED;
            PG8_LDB(B1, 0, 1); PG8_STAGE(PG8_SB(0, 0), b2, voffB);
            PG8_BAR; PG8_WAIT_L(0); PG8_MMA(0, 1, At, B1); PG8_BAR;
            PG8_LDA(At, 0, 1); PG8_STAGE(PG8_SA(0, 0), a2, voffA);
            PG8_BAR; PG8_WAIT_L(0); PG8_MMA(1, 0, At, B0); PG8_BAR; PG8_SCHED;
            PG8_STAGE(PG8_SB(0, 1), b2 + hstep, voffB);
            PG8_WAIT_V(6); PG8_BAR; PG8_MMA(1, 1, At, B1); PG8_BAR;
            PG8_LDB(B0, 1, 0); PG8_SCHED; PG8_LDA(At, 1, 0); PG8_STAGE(PG8_SA(0, 1), a2 + hstep, voffA);
            PG8_WAIT_L(8); PG8_BAR; PG8_WAIT_L(0); PG8_MMA(0, 0, At, B0); PG8_BAR; PG8_SCHED;
            PG8_LDB(B1, 1, 1); PG8_STAGE(PG8_SB(1, 0), b3, voffB);
            PG8_BAR; PG8_WAIT_L(0); PG8_MMA(0, 1, At, B1); PG8_BAR;
            PG8_LDA(At, 1, 1); PG8_STAGE(PG8_SA(1, 0), a3, voffA);
            PG8_BAR; PG8_WAIT_L(0); PG8_MMA(1, 0, At, B0); PG8_BAR; PG8_SCHED;
            PG8_STAGE(PG8_SB(1, 1), b3 + hstep, voffB);
            PG8_WAIT_V(6); PG8_BAR; PG8_MMA(1, 1, At, B1); PG8_BAR;
            }
        }
        if constexpr (ALIGN_EPI) { if (wr == 0) PG8_BAR; }
        E(acc, cur, wr, wc, fr, fq);
        if (!has_next) break;
#pragma unroll
        for (int a = 0; a < 2; ++a)
#pragma unroll
            for (int b = 0; b < 2; ++b)
#pragma unroll
                for (int m = 0; m < 4; ++m)
#pragma unroll
                    for (int n = 0; n < 2; ++n) acc[a][b][m][n] = (f32x4){0.f, 0.f, 0.f, 0.f};
        cur = nxt; cA = nA; cB = nB; ++ui;
        if constexpr (ALIGN_EPI) { if (wr == 1) PG8_BAR; }
    }
    PG8_WAIT_V(0);
    if constexpr (!ALIGN_EPI) { if (wr == 0) PG8_BAR; }
    PG8_BAR;
#undef PG8_SA
#undef PG8_SB
#undef PG8_STAGE
#undef PG8_LDA
#undef PG8_LDB
#undef PG8_MMA
#undef PG8_WAIT_V
#undef PG8_WAIT_L
#undef PG8_BAR
#undef PG8_SCHED
}

typedef f32x4 Acc[2][2][4][2];

struct EpiSwiGLU {
    bf16_t* O; const u64* ssq;
    __device__ __forceinline__ void operator()(const Acc& acc, const Unit& u, int wr, int wc, int fr, int fq) const {
        const int row0 = u.pm * BM + wr * 64 + fr, col0 = u.pn * 128 + wc * 32 + 8 * fq;
        float rsv[2][4];
#pragma unroll
        for (int ai = 0; ai < 2; ++ai)
#pragma unroll
            for (int m = 0; m < 4; ++m) rsv[ai][m] = rstd_of(ssq[row0 + ai * HALF + m * 16]);
#pragma unroll
        for (int ai = 0; ai < 2; ++ai)
#pragma unroll
            for (int m = 0; m < 4; ++m) {
                asm volatile("" ::: "memory");
                const int r = row0 + ai * HALF + m * 16; const float rs = rsv[ai][m]; const float na = -rs * LOG2E, rs2 = rs * rs;
                const f32x4 g0 = acc[ai][0][m][0], g1 = acc[ai][0][m][1], u0 = acc[ai][1][m][0], u1 = acc[ai][1][m][1];
                const f32x2 oa = swiglu2((f32x2){g0[0], g0[1]}, (f32x2){u0[0], u0[1]}, na, rs2), ob = swiglu2((f32x2){g0[2], g0[3]}, (f32x2){u0[2], u0[3]}, na, rs2);
                const f32x2 oc = swiglu2((f32x2){g1[0], g1[1]}, (f32x2){u1[0], u1[1]}, na, rs2), od = swiglu2((f32x2){g1[2], g1[3]}, (f32x2){u1[2], u1[3]}, na, rs2);
                u32x4 w; w.x = cvt_pk_bf16(oa.x, oa.y); w.y = cvt_pk_bf16(ob.x, ob.y); w.z = cvt_pk_bf16(oc.x, oc.y); w.w = cvt_pk_bf16(od.x, od.y);
                *(u32x4*)(O + (size_t)r * DFF + col0) = w;
            }
    }
};

struct EpiResid {
    const float* Hsrc; float* Hdst; bf16_t* HB; u64* ssq_out; int dry;
    __device__ __forceinline__ void operator()(const Acc& acc, const Unit& u, int wr, int wc, int fr, int fq) const {
        const int row0 = u.pm * BM + wr * 64 + fr, col0 = u.pn * BM + wc * 32 + 8 * fq;
#pragma unroll
        for (int ai = 0; ai < 2; ++ai)
#pragma unroll
            for (int m = 0; m < 4; ++m) {
                if ((m & 1) == 0) asm volatile("" ::: "memory");
                const int r = row0 + ai * HALF + m * 16; float part = 0.f;
#pragma unroll
                for (int bj = 0; bj < 2; ++bj) {
                    const size_t off = (size_t)r * D + col0 + bj * HALF;
                    const f32x4 h0 = *(const f32x4*)(Hsrc + off), h1 = *(const f32x4*)(Hsrc + off + 4);
                    const f32x4 v0 = h0 + acc[ai][bj][m][0], v1 = h1 + acc[ai][bj][m][1];
                    if (!dry) { *(f32x4*)(Hdst + off) = v0; *(f32x4*)(Hdst + off + 4) = v1; }
                    u32x4 w; w.x = cvt_pk_bf16(v0[0], v0[1]); w.y = cvt_pk_bf16(v0[2], v0[3]); w.z = cvt_pk_bf16(v1[0], v1[1]); w.w = cvt_pk_bf16(v1[2], v1[3]);
                    if (!dry) *(u32x4*)(HB + off) = w;
                    part += v0[0] * v0[0] + v0[1] * v0[1] + v0[2] * v0[2] + v0[3] * v0[3] + v1[0] * v1[0] + v1[1] * v1[1] + v1[2] * v1[2] + v1[3] * v1[3];
                }
                part += __shfl_xor(part, 16); part += __shfl_xor(part, 32);
                if (fq == 0 && !dry) atomicAdd(ssq_out + r, ssq_fix(part));
            }
    }
};

struct EpiRowScale {
    bf16_t* O; int ldc; const u64* ssq;
    __device__ __forceinline__ void operator()(const Acc& acc, const Unit& u, int wr, int wc, int fr, int fq) const {
        const int row0 = u.pm * BM + wr * 64 + fr, col0 = u.pn * BM + wc * 32 + 8 * fq;
        float rsv[2][4];
#pragma unroll
        for (int ai = 0; ai < 2; ++ai)
#pragma unroll
            for (int m = 0; m < 4; ++m) rsv[ai][m] = rstd_of(ssq[row0 + ai * HALF + m * 16]);
#pragma unroll
        for (int ai = 0; ai < 2; ++ai)
#pragma unroll
            for (int m = 0; m < 4; ++m) {
                asm volatile("" ::: "memory");
                const int r = row0 + ai * HALF + m * 16; const float rs = rsv[ai][m];
#pragma unroll
                for (int bj = 0; bj < 2; ++bj) {
                    const f32x4 v0 = acc[ai][bj][m][0] * rs, v1 = acc[ai][bj][m][1] * rs;
                    u32x4 w; w.x = cvt_pk_bf16(v0[0], v0[1]); w.y = cvt_pk_bf16(v0[2], v0[3]); w.z = cvt_pk_bf16(v1[0], v1[1]); w.w = cvt_pk_bf16(v1[2], v1[3]);
                    *(u32x4*)(O + (size_t)r * ldc + col0 + bj * HALF) = w;
                }
            }
    }
};

struct EpiWin {
    unsigned char* ws; const u64* ssq;
    __device__ __forceinline__ void operator()(const Acc& acc, const Unit& u, int wr, int wc, int fr, int fq) const {
        const int pn = u.pn; const int row0 = u.pm * BM + wr * 64 + fr;
        bf16_t* base; int ldc, colt, act = 0;
        if (pn < 4) { base = (bf16_t*)(ws + Z_U); ldc = 1024; colt = pn * 256; act = 1; }
        else if (pn < 8) { base = (bf16_t*)(ws + Z_V); ldc = 1024; colt = (pn - 4) * 256; act = 1; }
        else if (pn < 12) { base = (bf16_t*)(ws + Z_FQ); ldc = 1024; colt = (pn - 8) * 256; }
        else if (pn < 16) { base = (bf16_t*)(ws + Z_FK); ldc = 1024; colt = (pn - 12) * 256; }
        else if (pn < 20) { base = (bf16_t*)(ws + Z_FV); ldc = 1024; colt = (pn - 16) * 256; }
        else if (pn < 22) { base = (bf16_t*)(ws + Z_GQ); ldc = 512; colt = (pn - 20) * 256; }
        else if (pn < 24) { base = (bf16_t*)(ws + Z_GK); ldc = 512; colt = (pn - 22) * 256; }
        else if (pn < 28) { base = (bf16_t*)(ws + Z_GV); ldc = 1024; colt = (pn - 24) * 256; }
        else if (pn < 32) { base = (bf16_t*)(ws + Z_GR); ldc = 1024; colt = (pn - 28) * 256; }
        else { base = (bf16_t*)(ws + Z_GATES); ldc = 6144; colt = (pn - 32) * 256; act = 2; }
        const int col0 = colt + wc * 32 + 8 * fq;
        float rsv[2][4];
#pragma unroll
        for (int ai = 0; ai < 2; ++ai)
#pragma unroll
            for (int m = 0; m < 4; ++m) rsv[ai][m] = rstd_of(ssq[row0 + ai * HALF + m * 16]);
#pragma unroll
        for (int ai = 0; ai < 2; ++ai)
#pragma unroll
            for (int m = 0; m < 4; ++m) {
                asm volatile("" ::: "memory");
                const int r = row0 + ai * HALF + m * 16; const float rs = rsv[ai][m];
#pragma unroll
                for (int bj = 0; bj < 2; ++bj) {
                    const f32x4 x0 = acc[ai][bj][m][0], x1 = acc[ai][bj][m][1];
                    f32x2 a, b, c, d;
                    if (act == 1) { a = gelu2((f32x2){x0[0], x0[1]}, rs); b = gelu2((f32x2){x0[2], x0[3]}, rs); c = gelu2((f32x2){x1[0], x1[1]}, rs); d = gelu2((f32x2){x1[2], x1[3]}, rs); }
                    else if (act == 2) { const float na = -rs * LOG2E; a = sigmoid2((f32x2){x0[0], x0[1]}, na); b = sigmoid2((f32x2){x0[2], x0[3]}, na); c = sigmoid2((f32x2){x1[0], x1[1]}, na); d = sigmoid2((f32x2){x1[2], x1[3]}, na); }
                    else { a = (f32x2){x0[0], x0[1]} * rs; b = (f32x2){x0[2], x0[3]} * rs; c = (f32x2){x1[0], x1[1]} * rs; d = (f32x2){x1[2], x1[3]} * rs; }
                    u32x4 w; w.x = cvt_pk_bf16(a.x, a.y); w.y = cvt_pk_bf16(b.x, b.y); w.z = cvt_pk_bf16(c.x, c.y); w.w = cvt_pk_bf16(d.x, d.y);
                    *(u32x4*)(base + (size_t)r * ldc + col0 + bj * HALF) = w;
                }
            }
    }
};

struct EpiBranch {
    const bf16_t* gates; float* M32; bf16_t* MB; bf16_t* MA; int br;
    __device__ __forceinline__ void operator()(const Acc& acc, const Unit& u, int wr, int wc, int fr, int fq) const {
        const int row0 = u.pm * BM + wr * 64 + fr, col0 = u.pn * BM + wc * 32 + 8 * fq;
#pragma unroll
        for (int ai = 0; ai < 2; ++ai)
#pragma unroll
            for (int m = 0; m < 4; ++m) {
                if ((m & 1) == 0) asm volatile("" ::: "memory");
                const int r = row0 + ai * HALF + m * 16;
#pragma unroll
                for (int bj = 0; bj < 2; ++bj) {
                    const int c = col0 + bj * HALF; const size_t off = (size_t)r * D + c;
                    const u32x4 gw = *(const u32x4*)(gates + (size_t)r * 6144 + br * D + c);
                    f32x4 v0, v1;
                    v0[0] = acc[ai][bj][m][0][0] * bflo(gw.x); v0[1] = acc[ai][bj][m][0][1] * bfhi(gw.x); v0[2] = acc[ai][bj][m][0][2] * bflo(gw.y); v0[3] = acc[ai][bj][m][0][3] * bfhi(gw.y);
                    v1[0] = acc[ai][bj][m][1][0] * bflo(gw.z); v1[1] = acc[ai][bj][m][1][1] * bfhi(gw.z); v1[2] = acc[ai][bj][m][1][2] * bflo(gw.w); v1[3] = acc[ai][bj][m][1][3] * bfhi(gw.w);
                    if (br == 1) { const u32x4 ma = *(const u32x4*)(MA + off);
                        v0[0] += bflo(ma.x); v0[1] += bfhi(ma.x); v0[2] += bflo(ma.y); v0[3] += bfhi(ma.y); v1[0] += bflo(ma.z); v1[1] += bfhi(ma.z); v1[2] += bflo(ma.w); v1[3] += bfhi(ma.w); }
                    if (br == 2) { v0 += *(const f32x4*)(M32 + off); v1 += *(const f32x4*)(M32 + off + 4); }
                    if (br == 1) { *(f32x4*)(M32 + off) = v0; *(f32x4*)(M32 + off + 4) = v1; }
                    else { u32x4 w; w.x = cvt_pk_bf16(v0[0], v0[1]); w.y = cvt_pk_bf16(v0[2], v0[3]); w.z = cvt_pk_bf16(v1[0], v1[1]); w.w = cvt_pk_bf16(v1[2], v1[3]);
                        *(u32x4*)((br == 0 ? MA : MB) + off) = w; }
                }
            }
    }
};
}

__device__ __forceinline__ f32x4 mfma16(bf16x8 a, bf16x8 b, f32x4 c) { return __builtin_amdgcn_mfma_f32_16x16x32_bf16(a, b, c, 0, 0, 0); }
__device__ __forceinline__ bf16x8 mk8(unsigned a, unsigned b, unsigned c, unsigned d) { u32x4 v; v.x = a; v.y = b; v.z = c; v.w = d; return __builtin_bit_cast(bf16x8, v); }
__device__ __forceinline__ float wave_sum(float v) {
#pragma unroll
    for (int d = 1; d < 64; d <<= 1) v += __shfl_xor(v, d);
    return v;
}

template <int KIND> __device__ __forceinline__ int map_col(int n, float& sc) {
    sc = 1.f;
    if (KIND == 0) return n;
    if (KIND == 1) { const int pn = n >> 8, r = n & 255; return (r < 128) ? (pn * 128 + r) : (DFF + pn * 128 + (r - 128)); }
    if (n < 2048) return n;
    if (n < 3072) { sc = 0.08838834764831845f * LOG2E; return n; }
    if (n < 5120) return n;
    if (n < 5632) { sc = 0.08838834764831845f; return 5128 + (n - 5120); }
    if (n < 6144) return 5640 + (n - 5632);
    if (n < 7168) return 6152 + (n - 6144);
    if (n < 8192) return 7192 + (n - 7168);
    if (n < 14336) return 8216 + (n - 8192);
    n -= 14336;
    if (n < 8) return 5120 + n;
    if (n < 24) return 7176 + (n - 8);
    return -1;
}

template <int KIND>
__device__ __forceinline__ void prep_job(LAS unsigned char* lds, const float* W, int K, int Nsrc, bf16_t* Bt, int Ndst, const float* gain, float scale, int& base, int G, int w) {
    int tid_ = threadIdx.x; asm volatile("" : "+v"(tid_));
    const int tid = tid_;
    const int ntk = K / 64, ntiles = (Ndst / 256) * ntk;
    asm volatile("" : "+s"(w));
    const int t0 = ((w - base) % G + G) % G;
    base += ntiles;
    LAS bf16_t* tl = (LAS bf16_t*)lds;
    const int n4 = (tid & 63) * 4, kk = tid >> 6;
    for (int t = t0; t < ntiles; t += G) {
        const int tn = t / ntk, tk = t - tn * ntk, n0 = tn * 256, k0 = tk * 64;
        float sc; const int src = map_col<KIND>(n0 + n4, sc); sc *= scale;
        f32x4 v[8];
#pragma unroll
        for (int i = 0; i < 8; ++i) v[i] = (src >= 0) ? *(const f32x4*)(W + (size_t)(k0 + i * 8 + kk) * Nsrc + src) : (f32x4){0.f, 0.f, 0.f, 0.f};
#pragma unroll
        for (int i = 0; i < 8; ++i) {
            const int k = i * 8 + kk; const float gs = sc * (gain ? gain[k0 + k] : 1.f);
            LAS unsigned* p = (LAS unsigned*)(tl + k * 258 + n4);
            p[0] = cvt_pk_bf16(v[i][0] * gs, v[i][1] * gs); p[1] = cvt_pk_bf16(v[i][2] * gs, v[i][3] * gs);
        }
        __syncthreads();
#pragma unroll
        for (int i = 0; i < 4; ++i) {
            const int ch = i * 512 + tid, n = ch >> 3, kc = (ch & 7) * 8;
            const LAS bf16_t* q = tl + kc * 258 + n;
            u32x4 d;
            d.x = (unsigned)q[0 * 258] | ((unsigned)q[1 * 258] << 16); d.y = (unsigned)q[2 * 258] | ((unsigned)q[3 * 258] << 16);
            d.z = (unsigned)q[4 * 258] | ((unsigned)q[5 * 258] << 16); d.w = (unsigned)q[6 * 258] | ((unsigned)q[7 * 258] << 16);
            *(u32x4*)(Bt + (size_t)(n0 + n) * K + k0 + kc) = d;
        }
        __syncthreads();
    }
}

__device__ __forceinline__ void rows_to_bf16(const float* X, bf16_t* XB, u64* ssq, int rows, int gw, int nw) {
    int tid_ = threadIdx.x; asm volatile("" : "+v"(tid_)); asm volatile("" : "+v"(gw));
    const int lane = tid_ & 63;
    for (int r = gw; r < rows; r += nw) {
        const float* xr = X + (size_t)r * D; bf16_t* br = XB + (size_t)r * D; float ss = 0.f;
#pragma unroll
        for (int i = 0; i < 8; ++i) {
            const f32x4 v = *(const f32x4*)(xr + (i * 64 + lane) * 4);
            ss += v[0] * v[0] + v[1] * v[1] + v[2] * v[2] + v[3] * v[3];
            u32x2 w; w.x = cvt_pk_bf16(v[0], v[1]); w.y = cvt_pk_bf16(v[2], v[3]);
            *(u32x2*)(br + (i * 64 + lane) * 4) = w;
        }
        ss = wave_sum(ss);
        if (lane == 0) ssq[r] = ssq_fix(ss);
    }
}

__device__ __forceinline__ void narrow_cols_unit(LAS unsigned char* lds, int rb, const bf16_t* HB, const bf16_t* Btn, const u64* ssq, const float* b_f, float* LOGF, float* GA) {
    int tid_ = threadIdx.x; asm volatile("" : "+v"(tid_));
    const int tid = tid_, wid = __builtin_amdgcn_readfirstlane(tid >> 6), lane = tid & 63, fr = lane & 15, fq = lane >> 4, rg = wid & 3, kh = wid >> 2;
    const bf16_t* arow = HB + (size_t)(rb * 64 + rg * 16 + fr) * D + kh * 1024 + fq * 8;
    const bf16_t* b0 = Btn + (size_t)fr * D + kh * 1024 + fq * 8;
    const bf16_t* b1 = Btn + (size_t)(16 + fr) * D + kh * 1024 + fq * 8;
    f32x4 acc0 = (f32x4){0.f, 0.f, 0.f, 0.f}, acc1 = acc0;
#pragma unroll 8
    for (int ks = 0; ks < 32; ++ks) {
        const bf16x8 af = *(const bf16x8*)(arow + ks * 32), bf0 = *(const bf16x8*)(b0 + ks * 32), bf1 = *(const bf16x8*)(b1 + ks * 32);
        acc0 = mfma16(bf0, af, acc0); acc1 = mfma16(bf1, af, acc1);
    }
    LAS f32x4* red = (LAS f32x4*)lds;
    __syncthreads();
    if (kh == 1) { red[(rg * 2 + 0) * 64 + lane] = acc0; red[(rg * 2 + 1) * 64 + lane] = acc1; }
    __syncthreads();
    if (kh == 0) {
        acc0 += red[(rg * 2 + 0) * 64 + lane]; acc1 += red[(rg * 2 + 1) * 64 + lane];
        const int r = rb * 64 + rg * 16 + fr; const float rs = rstd_of(ssq[r]);
        if (fq < 2) {
            const f32x4 bf = *(const f32x4*)(b_f + fq * 4); f32x4 v;
#pragma unroll
            for (int e = 0; e < 4; ++e) v[e] = logsigmoidf_(acc0[e] * rs + bf[e]);
            *(f32x4*)(LOGF + (size_t)r * 8 + fq * 4) = v;
            *(f32x4*)(GA + (size_t)r * 16 + 8 + fq * 4) = acc1 * rs;
        } else {
            *(f32x4*)(GA + (size_t)r * 16 + (fq - 2) * 4) = acc0 * rs;
        }
    }
}

template <bool FOX>
__device__ __forceinline__ void attn_tile(LAS bf16_t* Ks, LAS bf16_t* Vt, LAS float* cum, int j, bool diag, int fr, int fq, const int (&qpos)[2], const float (&cq)[2],
                                          const bf16x8 (&qf)[2][4], f32x4 (&o)[2][8], float (&m_run)[2], float (&l_run)[2]) {
    f32x4 s[2][4];
#pragma unroll
    for (int mt = 0; mt < 4; ++mt) {
        s[0][mt] = (f32x4){0.f, 0.f, 0.f, 0.f}; s[1][mt] = (f32x4){0.f, 0.f, 0.f, 0.f};
#pragma unroll
        for (int ks = 0; ks < 4; ++ks) { const bf16x8 kf = *(const LAS bf16x8*)(Ks + (mt * 16 + fr) * 136 + ks * 32 + fq * 8); s[0][mt] = mfma16(kf, qf[0][ks], s[0][mt]); s[1][mt] = mfma16(kf, qf[1][ks], s[1][mt]); }
    }
    if (FOX) {
#pragma unroll
        for (int mt = 0; mt < 4; ++mt) { const f32x4 ck = *(const LAS f32x4*)(cum + j * 64 + mt * 16 + fq * 4);
#pragma unroll
            for (int e = 0; e < 4; ++e) { s[0][mt][e] += cq[0] - ck[e]; s[1][mt][e] += cq[1] - ck[e]; } }
        if (diag) {
#pragma unroll
            for (int g = 0; g < 2; ++g)
#pragma unroll
                for (int mt = 0; mt < 4; ++mt)
#pragma unroll
                    for (int e = 0; e < 4; ++e) if (j * 64 + mt * 16 + fq * 4 + e > qpos[g]) s[g][mt][e] = -INFINITY;
        }
    }
    bf16x8 pf[2][2];
#pragma unroll
    for (int g = 0; g < 2; ++g) {
        float mx = -INFINITY;
#pragma unroll
        for (int mt = 0; mt < 4; ++mt)
#pragma unroll
            for (int e = 0; e < 4; ++e) mx = fmaxf(mx, s[g][mt][e]);
        mx = fmaxf(mx, __shfl_xor(mx, 16)); mx = fmaxf(mx, __shfl_xor(mx, 32));
        const float m_new = fmaxf(m_run[g], mx);
        const float alpha = fexp2(m_run[g] - m_new);
        float ls = 0.f;
#pragma unroll
        for (int mt = 0; mt < 4; ++mt)
#pragma unroll
            for (int e = 0; e < 4; ++e) { const float p = fexp2(s[g][mt][e] - m_new); s[g][mt][e] = p; ls += p; }
        l_run[g] = l_run[g] * alpha + ls; m_run[g] = m_new;
#pragma unroll
        for (int i = 0; i < 8; ++i) o[g][i] *= alpha;
#pragma unroll
        for (int i = 0; i < 2; ++i) pf[g][i] = mk8(cvt_pk_bf16(s[g][2 * i][0], s[g][2 * i][1]), cvt_pk_bf16(s[g][2 * i][2], s[g][2 * i][3]), cvt_pk_bf16(s[g][2 * i + 1][0], s[g][2 * i + 1][1]), cvt_pk_bf16(s[g][2 * i + 1][2], s[g][2 * i + 1][3]));
    }
#pragma unroll
    for (int dt = 0; dt < 8; ++dt)
#pragma unroll
        for (int i = 0; i < 2; ++i) {
            const u32x2 lo = *(const LAS u32x2*)(Vt + (dt * 16 + fr) * 72 + i * 32 + fq * 4), hi2 = *(const LAS u32x2*)(Vt + (dt * 16 + fr) * 72 + i * 32 + 16 + fq * 4);
            const bf16x8 vf = mk8(lo.x, lo.y, hi2.x, hi2.y);
            o[0][dt] = mfma16(vf, pf[0][i], o[0][dt]); o[1][dt] = mfma16(vf, pf[1][i], o[1][dt]);
        }
}

template <bool FOX>
__device__ __forceinline__ void attn_unit(LAS unsigned char* lds, const bf16_t* Qp, int ldq, const bf16_t* Kp, const bf16_t* Vp, int ldkv, bf16_t* Op, int ldo,
                                          int ntiles  , int qpos0, const float* logf_bh, bool dry) {
    int tid_ = threadIdx.x; asm volatile("" : "+v"(tid_));
    const int tid = tid_, wid = __builtin_amdgcn_readfirstlane(tid >> 6), lane = tid & 63, fr = lane & 15, fq = lane >> 4;
    LAS bf16_t* Ks0 = (LAS bf16_t*)lds;
    LAS bf16_t* Vt0 = (LAS bf16_t*)(lds + 17408);
    LAS bf16_t* Ks1 = (LAS bf16_t*)(lds + 35840);
    LAS bf16_t* Vt1 = (LAS bf16_t*)(lds + 35840 + 17408);
    LAS float* cum = (LAS float*)(lds + 71680);
    LAS float* wsum = (LAS float*)(lds + 71680 + 8192);
    __syncthreads();
    if (FOX) {
        const int hi = ntiles * 64;
        float a0, a1, a2, a3;
        { const int i0 = 4 * tid; a0 = (i0 < hi) ? logf_bh[(size_t)i0 * 8] : 0.f; a1 = (i0 + 1 < hi) ? logf_bh[(size_t)(i0 + 1) * 8] : 0.f;
          a2 = (i0 + 2 < hi) ? logf_bh[(size_t)(i0 + 2) * 8] : 0.f; a3 = (i0 + 3 < hi) ? logf_bh[(size_t)(i0 + 3) * 8] : 0.f; }
        a1 += a0; a2 += a1; a3 += a2;
        float tot = a3;
#pragma unroll
        for (int d = 1; d < 64; d <<= 1) { const float t = __shfl_up(tot, d); if (lane >= d) tot += t; }
        if (lane == 63) wsum[wid] = tot;
        __syncthreads();
        float basep = 0.f;
        for (int w = 0; w < wid; ++w) basep += wsum[w];
        const float ex = basep + tot - a3;
        cum[4 * tid + 0] = (ex + a0) * LOG2E; cum[4 * tid + 1] = (ex + a1) * LOG2E; cum[4 * tid + 2] = (ex + a2) * LOG2E; cum[4 * tid + 3] = (ex + a3) * LOG2E;
        __syncthreads();
    }
    bf16x8 qf[2][4];
#pragma unroll
    for (int g = 0; g < 2; ++g) { const bf16_t* qrow = Qp + (size_t)(wid * 32 + g * 16 + fr) * ldq;
#pragma unroll
        for (int ks = 0; ks < 4; ++ks) qf[g][ks] = *(const bf16x8*)(qrow + ks * 32 + fq * 8); }
    int qpos[2]; qpos[0] = qpos0 + wid * 32 + fr; qpos[1] = qpos[0] + 16;
    float cq[2]; cq[0] = FOX ? cum[qpos[0]] : 0.f; cq[1] = FOX ? cum[qpos[1]] : 0.f;
    float m_run[2] = {-INFINITY, -INFINITY}, l_run[2] = {0.f, 0.f};
    f32x4 o[2][8];
#pragma unroll
    for (int i = 0; i < 8; ++i) { o[0][i] = (f32x4){0.f, 0.f, 0.f, 0.f}; o[1][i] = (f32x4){0.f, 0.f, 0.f, 0.f}; }
    const int wave_last = qpos0 + wid * 32 + 31;
    u32x4 kA[2], vA[2], kB[2], vB[2];
#define ATT_LOAD(kr, vr, j) do { _Pragma("unroll") for (int i = 0; i < 2; ++i) { const int ch = tid + i * 512; \
        kr[i] = *(const u32x4*)(Kp + (size_t)((j) * 64 + (ch >> 4)) * ldkv + (ch & 15) * 8); \
        vr[i] = *(const u32x4*)(Vp + (size_t)((j) * 64 + lane) * ldkv + (wid + 8 * i) * 8); } } while (0)
#define ATT_STAGE(Ks, Vt, kr, vr) do { _Pragma("unroll") for (int i = 0; i < 2; ++i) { const int ch = tid + i * 512; \
        *(LAS u32x4*)(Ks + (ch >> 4) * 136 + (ch & 15) * 8) = kr[i]; \
        LAS bf16_t* vp = Vt + ((wid + 8 * i) * 8) * 72 + lane; \
        vp[0 * 72] = (bf16_t)(vr[i].x & 0xffffu); vp[1 * 72] = (bf16_t)(vr[i].x >> 16); vp[2 * 72] = (bf16_t)(vr[i].y & 0xffffu); vp[3 * 72] = (bf16_t)(vr[i].y >> 16); \
        vp[4 * 72] = (bf16_t)(vr[i].z & 0xffffu); vp[5 * 72] = (bf16_t)(vr[i].z >> 16); vp[6 * 72] = (bf16_t)(vr[i].w & 0xffffu); vp[7 * 72] = (bf16_t)(vr[i].w >> 16); } } while (0)
    ATT_LOAD(kA, vA, 0); ATT_LOAD(kB, vB, 1);
    ATT_STAGE(Ks0, Vt0, kA, vA);
    if (2 < ntiles) ATT_LOAD(kA, vA, 2);
    __syncthreads();
    for (int j = 0; j < ntiles; j += 2) {
        ATT_STAGE(Ks1, Vt1, kB, vB);
        if (j + 3 < ntiles) ATT_LOAD(kB, vB, j + 3);
        if (!FOX || j * 64 <= wave_last) attn_tile<FOX>(Ks0, Vt0, cum, j, FOX && (j >= ntiles - 4), fr, fq, qpos, cq, qf, o, m_run, l_run);
        __syncthreads();
        if (j + 2 < ntiles) { ATT_STAGE(Ks0, Vt0, kA, vA); }
        if (j + 4 < ntiles) ATT_LOAD(kA, vA, j + 4);
        if (!FOX || (j + 1) * 64 <= wave_last) attn_tile<FOX>(Ks1, Vt1, cum, j + 1, FOX && (j + 1 >= ntiles - 4), fr, fq, qpos, cq, qf, o, m_run, l_run);
        __syncthreads();
    }
#undef ATT_LOAD
#undef ATT_STAGE
#pragma unroll
    for (int g = 0; g < 2; ++g) {
        float l = l_run[g]; l += __shfl_xor(l, 16); l += __shfl_xor(l, 32);
        const float inv = frcp(l);
        bf16_t* orow = Op + (size_t)(wid * 32 + g * 16 + fr) * ldo + fq * 4;
#pragma unroll
        for (int dt = 0; dt < 8; ++dt) { u32x2 w; w.x = cvt_pk_bf16(o[g][dt][0] * inv, o[g][dt][1] * inv); w.y = cvt_pk_bf16(o[g][dt][2] * inv, o[g][dt][3] * inv); if (!dry) *(u32x2*)(orow + dt * 16) = w; }
    }
}

__device__ __forceinline__ void sgu_unit(LAS unsigned char* lds, int b, int n, int g, const bf16_t* V, bf16_t* U, const float* ln_g, const float* ln_b, const float* w_s, const float* b_s, bool dry) {
    int tid_ = threadIdx.x; asm volatile("" : "+v"(tid_));
    const int tid = tid_, wid = tid >> 6, lane = tid & 63, fr = lane & 15, fq = lane >> 4;
    LAS bf16_t* vt = (LAS bf16_t*)lds;
    LAS float* st = (LAS float*)(lds + 69632);
    const int r0 = b * SEQ + n * 128;
    __syncthreads();
    for (int rr = 0; rr < 16; ++rr) {
        const int s = wid * 16 + rr;
        const u32x2 raw = *(const u32x2*)(V + (size_t)(r0 + s) * 1024 + g * 256 + lane * 4);
        const float x0 = bflo(raw.x), x1 = bfhi(raw.x), x2 = bflo(raw.y), x3 = bfhi(raw.y);
        const float mean = wave_sum(x0 + x1 + x2 + x3) * (1.f / 256.f);
        const float d0 = x0 - mean, d1 = x1 - mean, d2 = x2 - mean, d3 = x3 - mean;
        const float var = wave_sum(d0 * d0 + d1 * d1 + d2 * d2 + d3 * d3) * (1.f / 256.f);
        if (lane == 0) { st[2 * s] = mean; st[2 * s + 1] = frsq(var + EPS); }
    }
    __syncthreads();
    {
        const int s = tid & 127, cg0 = (tid >> 7) * 64;
        const float mean = st[2 * s], rstd = st[2 * s + 1];
        const bf16_t* vrow = V + (size_t)(r0 + s) * 1024 + g * 256 + cg0;
#pragma unroll
        for (int i = 0; i < 8; ++i) {
            const u32x4 raw = *(const u32x4*)(vrow + i * 8);
            const f32x4 g0 = *(const f32x4*)(ln_g + g * 256 + cg0 + i * 8), g1 = *(const f32x4*)(ln_g + g * 256 + cg0 + i * 8 + 4);
            const f32x4 b0 = *(const f32x4*)(ln_b + g * 256 + cg0 + i * 8), b1 = *(const f32x4*)(ln_b + g * 256 + cg0 + i * 8 + 4);
            LAS bf16_t* p = vt + (cg0 + i * 8) * 136 + s;
            p[0 * 136] = f2bf((bflo(raw.x) - mean) * rstd * g0[0] + b0[0]); p[1 * 136] = f2bf((bfhi(raw.x) - mean) * rstd * g0[1] + b0[1]);
            p[2 * 136] = f2bf((bflo(raw.y) - mean) * rstd * g0[2] + b0[2]); p[3 * 136] = f2bf((bfhi(raw.y) - mean) * rstd * g0[3] + b0[3]);
            p[4 * 136] = f2bf((bflo(raw.z) - mean) * rstd * g1[0] + b1[0]); p[5 * 136] = f2bf((bfhi(raw.z) - mean) * rstd * g1[1] + b1[1]);
            p[6 * 136] = f2bf((bflo(raw.w) - mean) * rstd * g1[2] + b1[2]); p[7 * 136] = f2bf((bfhi(raw.w) - mean) * rstd * g1[3] + b1[3]);
        }
    }
    __syncthreads();
    f32x4 acc[16];
#pragma unroll
    for (int i = 0; i < 16; ++i) acc[i] = (f32x4){0.f, 0.f, 0.f, 0.f};
    const int t = 16 * wid + fr;
    const int nks = (16 * wid + 15) / 32 + 1;
    for (int ks = 0; ks < nks; ++ks) {
        const float* wp = w_s + ((size_t)g * 128 + t) * 128 + ks * 32 + fq * 8;
        f32x4 w0 = *(const f32x4*)wp, w1 = *(const f32x4*)(wp + 4);
        const int sb = ks * 32 + fq * 8;
#pragma unroll
        for (int e = 0; e < 4; ++e) { if (sb + e > t) w0[e] = 0.f; if (sb + 4 + e > t) w1[e] = 0.f; }
        const bf16x8 wf = mk8(cvt_pk_bf16(w0[0], w0[1]), cvt_pk_bf16(w0[2], w0[3]), cvt_pk_bf16(w1[0], w1[1]), cvt_pk_bf16(w1[2], w1[3]));
#pragma unroll
        for (int nt = 0; nt < 16; ++nt) { const bf16x8 vf = *(const LAS bf16x8*)(vt + (nt * 16 + fr) * 136 + ks * 32 + fq * 8); acc[nt] = mfma16(vf, wf, acc[nt]); }
    }
    const float bs = b_s[g * 128 + t];
    bf16_t* up = U + (size_t)(r0 + t) * 1024 + g * 256 + fq * 4;
#pragma unroll
    for (int nt = 0; nt < 16; ++nt) {
        const u32x2 uu = *(const u32x2*)(up + nt * 16);
        u32x2 w; w.x = cvt_pk_bf16(bflo(uu.x) * (acc[nt][0] + bs), bfhi(uu.x) * (acc[nt][1] + bs)); w.y = cvt_pk_bf16(bflo(uu.y) * (acc[nt][2] + bs), bfhi(uu.y) * (acc[nt][3] + bs));
        if (!dry) *(u32x2*)(up + nt * 16) = w;
    }
}

__device__ __forceinline__ void gla_pre_unit(LAS unsigned char* lds, int b, int h, int ci, unsigned char* ws, const float* w_gate, const float* b_gate) {
    int tid_ = threadIdx.x; asm volatile("" : "+v"(tid_));
    const int tid = tid_, wid = tid >> 6, lane = tid & 63, fr = lane & 15, fq = lane >> 4;
    LAS bf16_t* QT = (LAS bf16_t*)lds;
    LAS bf16_t* KT = (LAS bf16_t*)(lds + 17408);
    LAS bf16_t* QD = (LAS bf16_t*)(lds + 34816);
    LAS bf16_t* KDT = (LAS bf16_t*)(lds + 52224);
    LAS bf16_t* VT = (LAS bf16_t*)(lds + 70656);
    LAS bf16_t* ATT = (LAS bf16_t*)(lds + 107520);
    LAS float* GAL = (LAS float*)(lds + 116736);
    LAS float* SEGTOT = (LAS float*)(lds + 120832);
    LAS float* BFIRST = (LAS float*)(lds + 122880);
    LAS float* DECAY = (LAS float*)(lds + 123392);
    const bf16_t* GQ = (const bf16_t*)(ws + Z_GQ); const bf16_t* GK = (const bf16_t*)(ws + Z_GK); const bf16_t* GV = (const bf16_t*)(ws + Z_GV);
    const float* GA = (const float*)(ws + WS_GA);
    const int unit = (b * 4 + h) * 32 + ci;
    bf16_t* OI = (bf16_t*)(ws + WS_OI) + (size_t)unit * 16384;
    bf16_t* UC = (bf16_t*)(ws + WS_UC) + (size_t)unit * 32768;
    bf16_t* QDF = (bf16_t*)(ws + WS_QDF) + (size_t)unit * 8192;
    float* DEC = (float*)(ws + WS_DEC) + (size_t)unit * 128;
    const int c = tid & 127, seg = tid >> 7;
    const int rc = b * SEQ + ci * 64;
    __syncthreads();
    if (tid < 256) *(LAS f32x4*)(GAL + tid * 4) = *(const f32x4*)(GA + (size_t)rc * 16 + tid * 4);
#pragma unroll
    for (int i = 0; i < 4; ++i) {
        const int vc = (wid + 8 * i) * 8;
        const u32x4 raw = *(const u32x4*)(GV + (size_t)(rc + lane) * 1024 + h * 256 + vc);
        LAS bf16_t* vp = VT + vc * 72 + lane;
        vp[0 * 72] = (bf16_t)(raw.x & 0xffffu); vp[1 * 72] = (bf16_t)(raw.x >> 16); vp[2 * 72] = (bf16_t)(raw.y & 0xffffu); vp[3 * 72] = (bf16_t)(raw.y >> 16);
        vp[4 * 72] = (bf16_t)(raw.z & 0xffffu); vp[5 * 72] = (bf16_t)(raw.z >> 16); vp[6 * 72] = (bf16_t)(raw.w & 0xffffu); vp[7 * 72] = (bf16_t)(raw.w >> 16);
    }
    float wg[16];
#pragma unroll
    for (int j = 0; j < 16; ++j) wg[j] = w_gate[j * 512 + h * 128 + c];
    const float bg = b_gate[h * 128 + c];
    unsigned short qraw[16], kraw[16];
#pragma unroll
    for (int tt = 0; tt < 16; ++tt) { const int t = seg * 16 + tt; qraw[tt] = GQ[(size_t)(rc + t) * 512 + h * 128 + c]; kraw[tt] = GK[(size_t)(rc + t) * 512 + h * 128 + c]; }
    __syncthreads();
    float bc[16]; float run = 0.f;
#pragma unroll
    for (int tt = 0; tt < 16; ++tt) {
        const int t = seg * 16 + tt; float x = bg;
#pragma unroll
        for (int j4 = 0; j4 < 4; ++j4) { const f32x4 a = *(const LAS f32x4*)(GAL + t * 16 + j4 * 4); x += a[0] * wg[j4 * 4] + a[1] * wg[j4 * 4 + 1] + a[2] * wg[j4 * 4 + 2] + a[3] * wg[j4 * 4 + 3]; }
        run += logsigmoidf_(x) * (1.f / 16.f); bc[tt] = run;
    }
    SEGTOT[seg * 128 + c] = run; if (seg == 2) BFIRST[c] = bc[0];
    __syncthreads();
    {
        const float s0 = SEGTOT[c], s1 = SEGTOT[128 + c], s2 = SEGTOT[256 + c], s3 = SEGTOT[384 + c];
        const float offs = (seg == 0) ? 0.f : (seg == 1) ? s0 : (seg == 2) ? (s0 + s1) : (s0 + s1 + s2);
        const float blast = s0 + s1 + s2 + s3, bref = s0 + s1 + BFIRST[c];
        if (seg == 0) DECAY[c] = fexp2(blast * LOG2E);
#pragma unroll
        for (int tt = 0; tt < 16; ++tt) {
            const int t = seg * 16 + tt; const float B = offs + bc[tt];
            const float qv = bf2f(qraw[tt]), kv = bf2f(kraw[tt]);
            QT[t * 136 + c] = f2bf(qv * fexp2((B - bref) * LOG2E)); KT[t * 136 + c] = f2bf(kv * fexp2((bref - B) * LOG2E));
            QD[t * 136 + c] = f2bf(qv * fexp2(B * LOG2E)); KDT[c * 72 + t] = f2bf(kv * fexp2((blast - B) * LOG2E));
        }
    }
    __syncthreads();
#pragma unroll
    for (int q = 0; q < 2; ++q) {
        const int id = wid * 2 + q, tm = id >> 2, sn = id & 3;
        f32x4 a = (f32x4){0.f, 0.f, 0.f, 0.f};
        if (sn <= tm) {
#pragma unroll
            for (int ks = 0; ks < 4; ++ks) { const bf16x8 kf = *(const LAS bf16x8*)(KT + (sn * 16 + fr) * 136 + ks * 32 + fq * 8), qf = *(const LAS bf16x8*)(QT + (tm * 16 + fr) * 136 + ks * 32 + fq * 8); a = mfma16(kf, qf, a); }
            if (sn == tm) {
#pragma unroll
                for (int e = 0; e < 4; ++e) if (fq * 4 + e > fr) a[e] = 0.f;
            }
        }
        u32x2 w; w.x = cvt_pk_bf16(a[0], a[1]); w.y = cvt_pk_bf16(a[2], a[3]);
        *(LAS u32x2*)(ATT + (tm * 16 + fr) * 72 + sn * 16 + fq * 4) = w;
    }
#pragma unroll
    for (int j = 0; j < 2; ++j) {
        const int id = tid + 512 * j, pair = id >> 6, tt = pair >> 2, i = pair & 3, ln = id & 63, fr2 = ln & 15, fq2 = ln >> 4;
        const u32x2 lo = *(const LAS u32x2*)(QD + (tt * 16 + fr2) * 136 + 32 * i + fq2 * 4), hi2 = *(const LAS u32x2*)(QD + (tt * 16 + fr2) * 136 + 32 * i + 16 + fq2 * 4);
        u32x4 w; w.x = lo.x; w.y = lo.y; w.z = hi2.x; w.w = hi2.y;
        *(u32x4*)(QDF + (size_t)id * 8) = w;
    }
    if (tid < 128) DEC[tid] = DECAY[tid];
    __syncthreads();
    {
        f32x4 o[2][4];
#pragma unroll
        for (int vt = 0; vt < 2; ++vt)
#pragma unroll
            for (int tt = 0; tt < 4; ++tt) o[vt][tt] = (f32x4){0.f, 0.f, 0.f, 0.f};
#pragma unroll
        for (int ks = 0; ks < 2; ++ks) {
            const bf16x8 vf0 = *(const LAS bf16x8*)(VT + (32 * wid + fr) * 72 + ks * 32 + fq * 8), vf1 = *(const LAS bf16x8*)(VT + (32 * wid + 16 + fr) * 72 + ks * 32 + fq * 8);
#pragma unroll
            for (int tt = 0; tt < 4; ++tt) {
                if (tt * 16 + 15 >= ks * 32) {
                    const bf16x8 af = *(const LAS bf16x8*)(ATT + (tt * 16 + fr) * 72 + ks * 32 + fq * 8);
                    o[0][tt] = mfma16(vf0, af, o[0][tt]); o[1][tt] = mfma16(vf1, af, o[1][tt]);
                }
            }
        }
#pragma unroll
        for (int tt = 0; tt < 4; ++tt) {
            u32x4 w; w.x = cvt_pk_bf16(o[0][tt][0], o[0][tt][1]); w.y = cvt_pk_bf16(o[0][tt][2], o[0][tt][3]); w.z = cvt_pk_bf16(o[1][tt][0], o[1][tt][1]); w.w = cvt_pk_bf16(o[1][tt][2], o[1][tt][3]);
            *(u32x4*)(OI + ((wid * 4 + tt) * 64 + lane) * 8) = w;
        }
    }
    {
        const bf16x8 vf00 = *(const LAS bf16x8*)(VT + (32 * wid + fr) * 72 + fq * 8), vf01 = *(const LAS bf16x8*)(VT + (32 * wid + fr) * 72 + 32 + fq * 8);
        const bf16x8 vf10 = *(const LAS bf16x8*)(VT + (32 * wid + 16 + fr) * 72 + fq * 8), vf11 = *(const LAS bf16x8*)(VT + (32 * wid + 16 + fr) * 72 + 32 + fq * 8);
#pragma unroll
        for (int mt = 0; mt < 8; ++mt) {
            const bf16x8 kf0 = *(const LAS bf16x8*)(KDT + (mt * 16 + fr) * 72 + fq * 8), kf1 = *(const LAS bf16x8*)(KDT + (mt * 16 + fr) * 72 + 32 + fq * 8);
            f32x4 u0 = (f32x4){0.f, 0.f, 0.f, 0.f}, u1 = u0;
            u0 = mfma16(kf0, vf00, u0); u0 = mfma16(kf1, vf01, u0);
            u1 = mfma16(kf0, vf10, u1); u1 = mfma16(kf1, vf11, u1);
            u32x4 w; w.x = cvt_pk_bf16(u0[0], u0[1]); w.y = cvt_pk_bf16(u0[2], u0[3]); w.z = cvt_pk_bf16(u1[0], u1[1]); w.w = cvt_pk_bf16(u1[2], u1[3]);
            *(u32x4*)(UC + ((wid * 8 + mt) * 64 + lane) * 8) = w;
        }
    }
}

__device__ __forceinline__ void gla_seq_unit(LAS unsigned char* lds, int b, int h, unsigned char* ws, const float* o_norm, bool dry) {
    int tid_ = threadIdx.x; asm volatile("" : "+v"(tid_));
    const int tid = tid_, wid = __builtin_amdgcn_readfirstlane(tid >> 6), lane = tid & 63, fr = lane & 15, fq = lane >> 4;
    LAS float* PART = (LAS float*)lds;
    LAS bf16_t* QDFL = (LAS bf16_t*)(lds + 2048);
    LAS float* DECL = (LAS float*)(lds + 2048 + 16384);
    bf16_t* GR = (bf16_t*)(ws + Z_GR);
    f32x4 S[8][2];
#pragma unroll
    for (int i = 0; i < 8; ++i) { S[i][0] = (f32x4){0.f, 0.f, 0.f, 0.f}; S[i][1] = (f32x4){0.f, 0.f, 0.f, 0.f}; }
    u32x4 ucp[8];
    { const bf16_t* UC0 = (const bf16_t*)(ws + WS_UC) + (size_t)((b * 4 + h) * 32) * 32768;
#pragma unroll
      for (int mt = 0; mt < 6; ++mt) ucp[mt] = *(const u32x4*)(UC0 + ((wid * 8 + mt) * 64 + lane) * 8); }
    for (int ci = 0; ci < 32; ++ci) {
        asm volatile("" ::: "memory");
        const int unit = (b * 4 + h) * 32 + ci, rc = b * SEQ + ci * 64;
        const bf16_t* OI = (const bf16_t*)(ws + WS_OI) + (size_t)unit * 16384;
        const bf16_t* UC = (const bf16_t*)(ws + WS_UC) + (size_t)unit * 32768;
        const bf16_t* QDF = (const bf16_t*)(ws + WS_QDF) + (size_t)unit * 8192;
        const float* DEC = (const float*)(ws + WS_DEC) + (size_t)unit * 128;
        const u32x4 qst0 = *(const u32x4*)(QDF + tid * 8), qst1 = *(const u32x4*)(QDF + (tid + 512) * 8);
        const float dst = DEC[tid & 127];
        u32x2 rr8[4][2];
#pragma unroll
        for (int tt = 0; tt < 4; ++tt)
#pragma unroll
            for (int vt = 0; vt < 2; ++vt) rr8[tt][vt] = *(const u32x2*)(GR + (size_t)(rc + tt * 16 + fr) * 1024 + h * 256 + 32 * wid + vt * 16 + fq * 4);
        ucp[6] = *(const u32x4*)(UC + ((wid * 8 + 6) * 64 + lane) * 8); ucp[7] = *(const u32x4*)(UC + ((wid * 8 + 7) * 64 + lane) * 8);
        u32x4 oip[4];
#pragma unroll
        for (int tt = 0; tt < 4; ++tt) oip[tt] = *(const u32x4*)(OI + ((wid * 4 + tt) * 64 + lane) * 8);
        __syncthreads();
        *(LAS u32x4*)(QDFL + tid * 8) = qst0; *(LAS u32x4*)(QDFL + (tid + 512) * 8) = qst1; if (tid < 128) DECL[tid] = dst;
        __syncthreads();
        f32x4 o[2][4];
#pragma unroll
        for (int tt = 0; tt < 4; ++tt) {
            o[0][tt][0] = bflo(oip[tt].x); o[0][tt][1] = bfhi(oip[tt].x); o[0][tt][2] = bflo(oip[tt].y); o[0][tt][3] = bfhi(oip[tt].y);
            o[1][tt][0] = bflo(oip[tt].z); o[1][tt][1] = bfhi(oip[tt].z); o[1][tt][2] = bflo(oip[tt].w); o[1][tt][3] = bfhi(oip[tt].w);
        }
#pragma unroll
        for (int i = 0; i < 4; ++i) {
            bf16x8 sf[2];
#pragma unroll
            for (int vt = 0; vt < 2; ++vt) sf[vt] = mk8(cvt_pk_bf16(S[2 * i][vt][0], S[2 * i][vt][1]), cvt_pk_bf16(S[2 * i][vt][2], S[2 * i][vt][3]), cvt_pk_bf16(S[2 * i + 1][vt][0], S[2 * i + 1][vt][1]), cvt_pk_bf16(S[2 * i + 1][vt][2], S[2 * i + 1][vt][3]));
#pragma unroll
            for (int tt = 0; tt < 4; ++tt) {
                const bf16x8 qf = *(const LAS bf16x8*)(QDFL + (tt * 4 + i) * 512 + lane * 8);
                o[0][tt] = mfma16(sf[0], qf, o[0][tt]); o[1][tt] = mfma16(sf[1], qf, o[1][tt]);
            }
        }
#pragma unroll
        for (int mt = 0; mt < 8; ++mt) {
            const f32x4 dec = *(const LAS f32x4*)(DECL + mt * 16 + fq * 4);
            f32x4 u0, u1; u0[0] = bflo(ucp[mt].x); u0[1] = bfhi(ucp[mt].x); u0[2] = bflo(ucp[mt].y); u0[3] = bfhi(ucp[mt].y); u1[0] = bflo(ucp[mt].z); u1[1] = bfhi(ucp[mt].z); u1[2] = bflo(ucp[mt].w); u1[3] = bfhi(ucp[mt].w);
            S[mt][0] = S[mt][0] * dec + u0; S[mt][1] = S[mt][1] * dec + u1;
        }
        asm volatile("" ::: "memory");
        { const bf16_t* UCn = UC + ((ci + 1 < 32) ? 32768 : 0);
#pragma unroll
          for (int mt = 0; mt < 6; ++mt) ucp[mt] = *(const u32x4*)(UCn + ((wid * 8 + mt) * 64 + lane) * 8); }
#pragma unroll
        for (int tt = 0; tt < 4; ++tt) {
            float p = 0.f;
#pragma unroll
            for (int vt = 0; vt < 2; ++vt)
#pragma unroll
                for (int e = 0; e < 4; ++e) p += o[vt][tt][e] * o[vt][tt][e];
            p += __shfl_xor(p, 16); p += __shfl_xor(p, 32);
            if (fq == 0) PART[wid * 64 + tt * 16 + fr] = p;
        }
        __syncthreads();
#pragma unroll
        for (int tt = 0; tt < 4; ++tt) {
            const int t = tt * 16 + fr; float tot = 0.f;
#pragma unroll
            for (int w = 0; w < 8; ++w) tot += PART[w * 64 + t];
            const float rs = frsq(tot * (1.f / 256.f) + EPS);
#pragma unroll
            for (int vt = 0; vt < 2; ++vt) {
                const int vcol = 32 * wid + vt * 16 + fq * 4;
                bf16_t* rp = GR + (size_t)(rc + t) * 1024 + h * 256 + vcol;
                const u32x2 rr = rr8[tt][vt]; const f32x4 on = *(const f32x4*)(o_norm + h * 256 + vcol);
                u32x2 w; w.x = cvt_pk_bf16(o[vt][tt][0] * rs * on[0] * siluf_(bflo(rr.x)), o[vt][tt][1] * rs * on[1] * siluf_(bfhi(rr.x)));
                w.y = cvt_pk_bf16(o[vt][tt][2] * rs * on[2] * siluf_(bflo(rr.y)), o[vt][tt][3] * rs * on[3] * siluf_(bfhi(rr.y)));
                if (!dry) *(u32x2*)rp = w;
            }
        }
    }
}
struct Args { const float* in[28]; float* out; unsigned char* ws; int ph_lo, ph_hi; };
constexpr int N_PHASES = 27;
constexpr int NPL = 13;


#define XB_TMO      128
#define XB_XCNT(j)  (256  + 64 * (j))
#define XB_XSUB(j)  (1280 + 64 * (j))
#define XB_XGEN(j)  (2304 + 64 * (j))
#define XB_TOP      3328
#define XB_TOPGEN   3392
#define XCD_BAR_WORDS 3456
#define XB_SPIN_CAP (1u << 18)
__device__ __forceinline__ unsigned xb_ld(unsigned* p)              { return __hip_atomic_load(p, __ATOMIC_RELAXED, __HIP_MEMORY_SCOPE_AGENT); }
__device__ __forceinline__ unsigned xb_add(unsigned* p, unsigned v) { return __hip_atomic_fetch_add(p, v, __ATOMIC_RELAXED, __HIP_MEMORY_SCOPE_AGENT); }
__device__ __forceinline__ unsigned xb_xcc_id() { return (unsigned)__builtin_amdgcn_s_getreg((3 << 11) | 20) & 0xFu; }
#define XB_SPIN(cond, bar) do { unsigned _sp = 0; while (cond) { __builtin_amdgcn_s_sleep(1); \
    if ((++_sp & 255u) == 0u) { if (xb_ld(&(bar)[XB_TMO])) break; if (_sp > XB_SPIN_CAP) { atomicAdd(&(bar)[XB_TMO], 1u); break; } } } } while (0)
__device__ __forceinline__ void xcd_barrier_complete(unsigned* bar, unsigned x, unsigned G, unsigned& nloc, unsigned& nx) {
    unsigned sum, cnt, mine, sp = 0u;
    for (;;) {
        sum = 0u; cnt = 0u; mine = 0u;
#pragma unroll
        for (unsigned j = 0; j < 16; ++j) { const unsigned c = xb_ld(&bar[XB_XCNT(j)]); sum += c; cnt += (c > 0u) ? 1u : 0u; mine = (j == x) ? c : mine; }
        if (sum == G) break;
        __builtin_amdgcn_s_sleep(1);
        if ((++sp & 255u) == 0u) { if (xb_ld(&bar[XB_TMO])) break; if (sp > XB_SPIN_CAP) { atomicAdd(&bar[XB_TMO], 1u); break; } }
    }
    nloc = mine > 0u ? mine : 1u; nx = cnt > 0u ? cnt : 1u;
}
__device__ __forceinline__ void xcd_barrier(unsigned* bar, volatile LAS unsigned* st, bool tid0, unsigned G) {
    asm volatile("s_waitcnt vmcnt(0)" ::: "memory");
    __syncthreads();
    if (tid0) {
        const unsigned x = xb_xcc_id();
        __builtin_amdgcn_s_waitcnt(0);
        unsigned nloc = st[0], nx = st[1];
        if (nloc == 0u) { xcd_barrier_complete(bar, x, G, nloc, nx); st[0] = nloc; st[1] = nx; }
        const unsigned old = xb_add(&bar[XB_XSUB(x)], 1u);
        const unsigned gen = old / nloc;
        if (old + 1u == (gen + 1u) * nloc) {
            __builtin_amdgcn_fence(__ATOMIC_RELEASE, "agent");
            asm volatile("s_waitcnt vmcnt(0)" ::: "memory");
            const unsigned og = xb_add(&bar[XB_TOP], 1u);
            const unsigned tg = og / nx;
            if (og + 1u == (tg + 1u) * nx) xb_add(&bar[XB_TOPGEN], 1u);
            else XB_SPIN(xb_ld(&bar[XB_TOPGEN]) == tg, bar);
            __builtin_amdgcn_fence(__ATOMIC_ACQUIRE, "agent");
            xb_add(&bar[XB_XGEN(x)], 1u);
            asm volatile("s_waitcnt vmcnt(0)" ::: "memory");
        } else {
            XB_SPIN(xb_ld(&bar[XB_XGEN(x)]) == gen, bar);
            __builtin_amdgcn_fence(__ATOMIC_ACQUIRE, "agent");
            asm volatile("s_waitcnt vmcnt(0)" ::: "memory");
        }
    }
    __syncthreads();
}

__device__ __forceinline__ int queue_pop(unsigned* ctr, LAS int* slot) {
    int tid_ = threadIdx.x; asm volatile("" : "+v"(tid_));
    __syncthreads();
    if (tid_ == 0) *slot = (int)atomicAdd(ctr, 1u);
    __syncthreads();
    return *slot;
}

__global__ void __launch_bounds__(NTHREADS, 2) fwd_kernel(Args a) {
    extern __shared__ __attribute__((aligned(16))) unsigned char lds_raw[];
    LAS unsigned char* lds = (LAS unsigned char*)lds_raw;
    typedef const __attribute__((address_space(4))) Args* KArgs;
    const int ph_lo = a.ph_lo, ph_hi = a.ph_hi;
    volatile LAS unsigned* xb_st = (volatile LAS unsigned*)(lds + MISC_OFF + 64);
    if (MK_LAUNCHES == 1) {
        if (threadIdx.x == 0) { xb_st[0] = 0u; xb_st[1] = 0u; (void)xb_add((unsigned*)(a.ws + WS_CTL + CTL_BAR) + XB_XCNT(xb_xcc_id()), 1u); }
        __syncthreads();
    }
#ifndef PROBE_RPT
#define PROBE_RPT (-1)
#endif
    constexpr int NVP = (PROBE_RPT >= 0) ? 2 : 0;
    for (int vp = ph_lo; vp < ph_hi + NVP; ++vp) {
        int ph = vp; bool dry = false;
        int tid = threadIdx.x; asm volatile("" : "+v"(tid));
        int G = gridDim.x, bx = blockIdx.x; asm volatile("" : "+s"(G), "+s"(bx));
        if (PROBE_RPT >= 0) {
            constexpr int P1 = PROBE_RPT, P2 = NPL + PROBE_RPT;
            if (vp <= P1) { ph = vp; dry = (vp == P1); } else if (vp <= P2 + 1) { ph = vp - 1; dry = (vp == P2 + 1); } else ph = vp - 2;
        }
        KArgs ap = (KArgs)__builtin_amdgcn_kernarg_segment_ptr(); asm volatile("" : "+s"(ap));
#define AIN(i) (ap->in[i])
        unsigned char* ws = ap->ws; float* out = ap->out;
        u64* ssq_all = (u64*)(ws + WS_CTL + CTL_SSQ);
        u64* ssqm = (u64*)(ws + WS_SSQM);
        unsigned* qctr = (unsigned*)(ws + WS_CTL);
        bf16_t* HB = (bf16_t*)(ws + WS_HB); bf16_t* MB = (bf16_t*)(ws + WS_MB); bf16_t* MEMB = (bf16_t*)(ws + WS_MEMB); bf16_t* KVB = (bf16_t*)(ws + WS_KV);
        bf16_t* ACT = (bf16_t*)(ws + WS_ACT); bf16_t* XQB = (bf16_t*)(ws + WS_XQB); bf16_t* XOB = (bf16_t*)(ws + WS_XOB);
        float* M32 = (float*)(ws + WS_M32);
        if (ph == 2 * NPL) {
            const u64* ssq = ssq_all + (size_t)8 * T; const float* fg = AIN(27);
            const int lane = tid & 63, gw = bx * 8 + (tid >> 6), nw = G * 8;
            for (int r = gw; r < T; r += nw) {
                const float rs = rstd_of(ssq[r]); float* hr = out + (size_t)r * D;
#pragma unroll
                for (int i = 0; i < 8; ++i) { const int cidx = (i * 64 + lane) * 4; const f32x4 v = *(const f32x4*)(hr + cidx); const f32x4 gg = *(const f32x4*)(fg + cidx); *(f32x4*)(hr + cidx) = v * rs * gg; }
            }
        } else {
            const int l = ph / NPL, k = ph - l * NPL;
            switch (k) {
#ifndef PH_MASK
#define PH_MASK 0xfff
#endif
            case 0: { if (!(PH_MASK & (1 << 0))) break;
                int base = 0;
                prep_job<1>(lds, AIN(3) + (size_t)l * D * 2 * DFF, D, 2 * DFF, (bf16_t*)(ws + W_FFN1_IN), 2 * DFF, AIN(2) + l * D, 1.f, base, G, bx);
                prep_job<0>(lds, AIN(4) + (size_t)l * DFF * D, DFF, D, (bf16_t*)(ws + W_FFN1_OUT), D, nullptr, 0.5f, base, G, bx);
                prep_job<2>(lds, AIN(6) + (size_t)l * D * 14360, D, 14360, (bf16_t*)(ws + W_IN), NINP, AIN(5) + l * D, 1.f, base, G, bx);
                prep_job<0>(lds, AIN(15) + (size_t)l * 1024 * D, 1024, D, (bf16_t*)(ws + W_BA), D, nullptr, 1.f, base, G, bx);
                prep_job<0>(lds, AIN(16) + (size_t)l * 1024 * D, 1024, D, (bf16_t*)(ws + W_BB), D, nullptr, 1.f, base, G, bx);
                prep_job<0>(lds, AIN(17) + (size_t)l * 1024 * D, 1024, D, (bf16_t*)(ws + W_BC), D, nullptr, 1.f, base, G, bx);
                prep_job<0>(lds, AIN(18) + (size_t)l * D * D, D, D, (bf16_t*)(ws + W_OUT), D, nullptr, 1.f, base, G, bx);
                prep_job<0>(lds, AIN(21) + (size_t)l * D * 512, D, 512, (bf16_t*)(ws + W_XQ), 512, AIN(19) + l * D, 0.08838834764831845f * LOG2E, base, G, bx);
                prep_job<0>(lds, AIN(22) + (size_t)l * D * 1024, D, 1024, (bf16_t*)(ws + W_XKV), 1024, AIN(20) + l * D, 1.f, base, G, bx);
                prep_job<0>(lds, AIN(23) + (size_t)l * 512 * D, 512, D, (bf16_t*)(ws + W_XO), D, nullptr, 1.f, base, G, bx);
                prep_job<1>(lds, AIN(25) + (size_t)l * D * 2 * DFF, D, 2 * DFF, (bf16_t*)(ws + W_FFN2_IN), 2 * DFF, AIN(24) + l * D, 1.f, base, G, bx);
                prep_job<0>(lds, AIN(26) + (size_t)l * DFF * D, DFF, D, (bf16_t*)(ws + W_FFN2_OUT), D, nullptr, 0.5f, base, G, bx);
                if (l == 0) {
                    const int gw = bx * 8 + (tid >> 6), nw = G * 8;
                    rows_to_bf16(AIN(0), HB, ssq_all, T, gw, nw);
                    rows_to_bf16(AIN(1), MEMB, ssqm, MEMT, gw, nw);
                }
            } break;
            case 1: case 11: { if (!(PH_MASK & (1 << 1))) break;
                pg8::Gemm g{HB, (const bf16_t*)(ws + (k == 1 ? W_FFN1_IN : W_FFN2_IN)), T, 2 * DFF, D};
                pg8::StaticOrder S; S.init(T, 2 * DFF, G, bx);
                pg8::EpiSwiGLU E{ACT, ssq_all + (size_t)(4 * l + (k == 1 ? 0 : 3)) * T};
                pg8::gemm_phase(lds, g, S, E);
            } break;
            case 2: case 12: { if (!(PH_MASK & (1 << 2))) break;
                pg8::Gemm g{ACT, (const bf16_t*)(ws + (k == 2 ? W_FFN1_OUT : W_FFN2_OUT)), T, D, DFF};
                pg8::StaticOrder S; S.init(T, D, G, bx);
                pg8::EpiResid E{(l == 0 && k == 2) ? AIN(0) : out, out, HB, ssq_all + (size_t)(4 * l + (k == 2 ? 1 : 4)) * T, (int)dry};
                pg8::gemm_phase(lds, g, S, E);
            } break;
            case 3: { if (!(PH_MASK & (1 << 3))) break;
                pg8::Gemm g{HB, (const bf16_t*)(ws + W_IN), T, NINP - 256, D};
                pg8::StaticOrder S; S.init(T, NINP - 256, G, bx);
                pg8::EpiWin E{ws, ssq_all + (size_t)(4 * l + 1) * T};
                pg8::gemm_phase(lds, g, S, E);
                for (int rb = bx; rb < T / 64; rb += G)
                    narrow_cols_unit(lds, rb, HB, (const bf16_t*)(ws + W_IN) + (size_t)(NINP - 256) * D, ssq_all + (size_t)(4 * l + 1) * T, AIN(11) + l * 8, (float*)(ws + WS_LOGF), (float*)(ws + WS_GA));
            } break;
            case 4: { if (!(PH_MASK & (1 << 4))) break;
                LAS int* slot = (LAS int*)(lds + MISC_OFF);
                for (;;) {
                    const int u = queue_pop(qctr + l + (dry ? 4 : 0), slot);
                    if (u >= 1024 + 512) break;
                    if (u < 1024) {
                        gla_pre_unit(lds, u >> 7, (u >> 5) & 3, u & 31, ws, AIN(12) + (size_t)l * 16 * 512, AIN(13) + l * 512);
                    } else {
                        const int s = u - 1024, g = s & 3, n = (s >> 2) & 15, b = s >> 6;
                        sgu_unit(lds, b, n, g, (const bf16_t*)(ws + Z_V), (bf16_t*)(ws + Z_U), AIN(7) + l * 1024, AIN(8) + l * 1024, AIN(9) + (size_t)l * 4 * 128 * 128, AIN(10) + l * 512, dry);
                    }
                }
            } break;
            case 5: { if (!(PH_MASK & (1 << 5))) break;
                if (bx < 32) { gla_seq_unit(lds, bx >> 2, bx & 3, ws, AIN(14) + l * 1024, dry); }
                else {
                    if (!dry) {
                        pg8::StaticOrder S; S.init(T, D, G - 32, bx - 32);
                        pg8::Gemm g{(const bf16_t*)(ws + Z_U), (const bf16_t*)(ws + W_BA), T, D, 1024}; pg8::EpiBranch E{(const bf16_t*)(ws + Z_GATES), M32, MB, (bf16_t*)(ws + WS_MA), 0}; pg8::gemm_phase(lds, g, S, E);
                    }
                    __syncthreads();
                    LAS int* slot = (LAS int*)(lds + MISC_OFF);
                    for (;;) {
                        const int q = queue_pop(qctr + 2 + l + (dry ? 4 : 0), slot);
                        if (q >= 512) break;
                        const int qb = 7 - (q >> 6), bh = q & 63, b = bh >> 3, h = bh & 7;
                        const size_t rb = (size_t)b * SEQ;
                        bf16_t* FQ = (bf16_t*)(ws + Z_FQ); const bf16_t* FK = (const bf16_t*)(ws + Z_FK); const bf16_t* FV = (const bf16_t*)(ws + Z_FV);
                        attn_unit<true>(lds, FQ + (rb + qb * 256) * 1024 + h * 128, 1024, FK + rb * 1024 + h * 128, FV + rb * 1024 + h * 128, 1024,
                                        FQ + (rb + qb * 256) * 1024 + h * 128, 1024, (qb + 1) * 4, qb * 256, (const float*)(ws + WS_LOGF) + rb * 8 + h, dry);
                    }
                }
            } break;
            case 6: { if (!(PH_MASK & (1 << 6))) break;
                pg8::StaticOrder S; S.init(T, D, G, bx);
                const bf16_t* gates = (const bf16_t*)(ws + Z_GATES);
                { pg8::Gemm g{(const bf16_t*)(ws + Z_FQ), (const bf16_t*)(ws + W_BB), T, D, 1024}; pg8::EpiBranch E{gates, M32, MB, (bf16_t*)(ws + WS_MA), 1}; pg8::gemm_phase(lds, g, S, E); }
                { pg8::Gemm g{(const bf16_t*)(ws + Z_GR), (const bf16_t*)(ws + W_BC), T, D, 1024}; pg8::EpiBranch E{gates, M32, MB, (bf16_t*)(ws + WS_MA), 2}; pg8::gemm_phase(lds, g, S, E); }
            } break;
            case 7: { if (!(PH_MASK & (1 << 7))) break;
                pg8::Gemm g{MB, (const bf16_t*)(ws + W_OUT), T, D, D};
                pg8::StaticOrder S; S.init(T, D, G, bx);
                pg8::EpiResid E{out, out, HB, ssq_all + (size_t)(4 * l + 2) * T, (int)dry};
                pg8::gemm_phase(lds, g, S, E);
            } break;
            case 8: { if (!(PH_MASK & (1 << 8))) break;
                { pg8::Gemm g{HB, (const bf16_t*)(ws + W_XQ), T, 512, D}; pg8::StaticOrder S; S.init(T, 512, G, bx);
                  pg8::EpiRowScale E{XQB, 512, ssq_all + (size_t)(4 * l + 2) * T}; pg8::gemm_phase(lds, g, S, E); }
                { pg8::Gemm g{MEMB, (const bf16_t*)(ws + W_XKV), MEMT, 1024, D}; pg8::StaticOrder S; S.init(MEMT, 1024, G, (bx + G - 128) % G);
                  pg8::EpiRowScale E{KVB, 1024, ssqm}; pg8::gemm_phase(lds, g, S, E); }
            } break;
            case 9: { if (!(PH_MASK & (1 << 9))) break;
                for (int u = bx; u < 256; u += G) {
                    const int qb = u & 7, h = (u >> 3) & 3, b = u >> 5;
                    const size_t rq = (size_t)b * SEQ + qb * 256, rk = (size_t)b * 256;
                    attn_unit<false>(lds, XQB + rq * 512 + h * 128, 512, KVB + rk * 1024 + h * 128, KVB + rk * 1024 + 512 + h * 128, 1024, XOB + rq * 512 + h * 128, 512, 4, 0, nullptr, false);
                }
            } break;
            case 10: { if (!(PH_MASK & (1 << 10))) break;
                pg8::Gemm g{XOB, (const bf16_t*)(ws + W_XO), T, D, 512};
                pg8::StaticOrder S; S.init(T, D, G, bx);
                pg8::EpiResid E{out, out, HB, ssq_all + (size_t)(4 * l + 3) * T, (int)dry};
                pg8::gemm_phase(lds, g, S, E);
            } break;
            default: break;
            }
        }
        if (vp + 1 < ph_hi + NVP) {
            if (vp == ph_lo) cg::this_grid().sync();
            else xcd_barrier((unsigned*)(ws + WS_CTL + CTL_BAR), xb_st, tid == 0, (unsigned)G);
        }
    }
}

extern "C" void kernel_launch(void* const* d_in, const int* in_sizes, int n_in, void* d_out, int out_size, void* d_ws, size_t ws_size, hipStream_t stream) {
    static int grid = 0;
    if (grid == 0) {
        if (n_in != 28 || out_size != T * D || ws_size < WS_END) { fprintf(stderr, "kernel_launch: unexpected shapes (n_in %d, out %d, ws %zu < %zu)\n", n_in, out_size, ws_size, (size_t)WS_END); grid = -1; return; }
        int dev = 0, cus = 0, per_cu = 0;
        hipGetDevice(&dev); hipDeviceGetAttribute(&cus, hipDeviceAttributeMultiprocessorCount, dev);
        if (hipFuncSetAttribute((const void*)fwd_kernel, hipFuncAttributeMaxDynamicSharedMemorySize, LDS_BYTES) != hipSuccess) { fprintf(stderr, "kernel_launch: hipFuncSetAttribute failed\n"); grid = -1; return; }
        if (hipOccupancyMaxActiveBlocksPerMultiprocessor(&per_cu, (const void*)fwd_kernel, NTHREADS, LDS_BYTES) != hipSuccess || per_cu < 1) { fprintf(stderr, "kernel_launch: occupancy query says %d\n", per_cu); per_cu = 1; }
        (void)hipGetLastError();
        grid = cus * 1;
    }
    if (grid < 0) return;
    (void)hipMemsetAsync((char*)d_ws + WS_CTL, 0, CTL_BYTES, stream);
    Args a{};
    for (int i = 0; i < 28; ++i) a.in[i] = (const float*)d_in[i];
    a.out = (float*)d_out; a.ws = (unsigned char*)d_ws;
#if MK_LAUNCHES == 1
    a.ph_lo = 0; a.ph_hi = N_PHASES;
    void* args[] = {&a};
    hipError_t e = hipLaunchCooperativeKernel((const void*)fwd_kernel, dim3(grid), dim3(NTHREADS), args, LDS_BYTES, stream);
    if (e != hipSuccess) fprintf(stderr, "cooperative launch failed: %s (grid %d)\n", hipGetErrorString(e), grid);
#else
    for (int p = 0; p < N_PHASES; ++p) {
        a.ph_lo = p; a.ph_hi = p + 1;
        hipLaunchKernelGGL(fwd_kernel, dim3(grid), dim3(NTHREADS), LDS_BYTES, stream, a);
    }
#endif
}
```

```cpp
#include <hip/hip_runtime.h>
#include <hip/hip_cooperative_groups.h>
#include <cstdio>
#include <cstdint>
namespace cg = cooperative_groups;

#ifndef MK_LAUNCHES
#define MK_LAUNCHES 1
#endif

#define LAS __attribute__((address_space(3)))
typedef unsigned short bf16_t;
typedef short bf16x8 __attribute__((ext_vector_type(8)));
typedef float f32x4 __attribute__((ext_vector_type(4)));
typedef unsigned u32x4 __attribute__((ext_vector_type(4)));
typedef unsigned u32x2 __attribute__((ext_vector_type(2)));

constexpr int T = 16384, D = 2048, DFF = 5632, SEQ = 2048, NB = 8, MEMT = 2048  ;
constexpr int NINP = 14592;
constexpr float EPS = 1e-6f;
constexpr float LOG2E = 1.4426950408889634f, LN2 = 0.6931471805599453f;
constexpr int NTHREADS = 512;
constexpr int LDS_BYTES = 133120;
constexpr int MISC_OFF = 131072;

constexpr size_t SZ_FFN_IN = (size_t)2 * DFF * D * 2, SZ_FFN_OUT = (size_t)D * DFF * 2, SZ_WIN = (size_t)NINP * D * 2, SZ_BR = (size_t)D * 1024 * 2, SZ_WOUT = (size_t)D * D * 2;
constexpr size_t SZ_XQ = (size_t)512 * D * 2, SZ_XKV = (size_t)1024 * D * 2, SZ_XO = (size_t)D * 512 * 2;
constexpr size_t W_FFN1_IN = 0, W_FFN1_OUT = W_FFN1_IN + SZ_FFN_IN, W_IN = W_FFN1_OUT + SZ_FFN_OUT, W_BA = W_IN + SZ_WIN, W_BB = W_BA + SZ_BR, W_BC = W_BB + SZ_BR,
                 W_OUT = W_BC + SZ_BR, W_XQ = W_OUT + SZ_WOUT, W_XKV = W_XQ + SZ_XQ, W_XO = W_XKV + SZ_XKV, W_FFN2_IN = W_XO + SZ_XO, W_FFN2_OUT = W_FFN2_IN + SZ_FFN_IN,
                 W_END = W_FFN2_OUT + SZ_FFN_OUT;
constexpr size_t WS_CTL = W_END;
constexpr size_t CTL_BAR = 4096;
constexpr size_t CTL_SSQ = 4096 + 16384;
constexpr size_t CTL_BYTES = CTL_SSQ + (size_t)9 * T * 8;
constexpr size_t WS_SSQM = WS_CTL + CTL_BYTES;
constexpr size_t WS_HB = WS_SSQM + 16384;
constexpr size_t WS_MB = WS_HB + (size_t)T * D * 2;
constexpr size_t WS_MEMB = WS_MB + (size_t)T * D * 2;
constexpr size_t WS_KV = WS_MEMB + (size_t)MEMT * D * 2;
constexpr size_t WS_LOGF = WS_KV + (size_t)MEMT * 1024 * 2;
constexpr size_t WS_GA = WS_LOGF + (size_t)T * 8 * 4;
constexpr size_t WS_Z = WS_GA + (size_t)T * 16 * 4;
constexpr size_t Z_U = WS_Z, Z_FQ = Z_U + (size_t)T * 1024 * 2, Z_GR = Z_FQ + (size_t)T * 1024 * 2, Z_GATES = Z_GR + (size_t)T * 1024 * 2,
                 Z_V = Z_GATES + (size_t)T * 6144 * 2, Z_FK = Z_V + (size_t)T * 1024 * 2, Z_FV = Z_FK + (size_t)T * 1024 * 2, Z_GQ = Z_FV + (size_t)T * 1024 * 2,
                 Z_GK = Z_GQ + (size_t)T * 512 * 2, Z_GV = Z_GK + (size_t)T * 512 * 2, Z_END = Z_GV + (size_t)T * 1024 * 2;
constexpr size_t WS_MA = Z_GQ;
constexpr size_t WS_ACT = WS_Z;
constexpr size_t WS_XQB = WS_Z, WS_XOB = WS_Z + (size_t)T * 512 * 2;
constexpr size_t WS_OI = WS_MB;
constexpr size_t WS_UC = Z_END;
constexpr size_t WS_M32 = WS_UC;
constexpr size_t WS_QDF = WS_UC + (size_t)1024 * 32768 * 4;
constexpr size_t WS_DEC = WS_QDF + (size_t)1024 * 8192 * 2;
constexpr size_t WS_END = WS_DEC + (size_t)1024 * 128 * 4;
static_assert(WS_MA + (size_t)T * D * 2 <= Z_END && WS_ACT + (size_t)T * DFF * 2 <= Z_END, "aliases fit");
static_assert(WS_CTL % 256 == 0 && WS_HB % 256 == 0 && WS_Z % 256 == 0, "alignment");

typedef float f32x2_t __attribute__((ext_vector_type(2)));
typedef __bf16 bf16x2_t __attribute__((ext_vector_type(2)));
__device__ __forceinline__ unsigned cvt_pk_bf16(float lo, float hi) { const f32x2_t v = {lo, hi}; const bf16x2_t b = __builtin_convertvector(v, bf16x2_t); return __builtin_bit_cast(unsigned, b); }
__device__ __forceinline__ float bflo(unsigned u) { return __builtin_bit_cast(float, u << 16); }
__device__ __forceinline__ float bfhi(unsigned u) { return __builtin_bit_cast(float, u & 0xffff0000u); }
__device__ __forceinline__ float bf2f(bf16_t b) { return __builtin_bit_cast(float, ((unsigned)b) << 16); }
__device__ __forceinline__ bf16_t f2bf(float f) { return (bf16_t)(cvt_pk_bf16(f, 0.f) & 0xffffu); }
__device__ __forceinline__ float fexp2(float x) { return __builtin_amdgcn_exp2f(x); }
__device__ __forceinline__ float flog2(float x) { return __builtin_amdgcn_logf(x); }
__device__ __forceinline__ float frcp(float x) { return __builtin_amdgcn_rcpf(x); }
__device__ __forceinline__ float frsq(float x) { return __builtin_amdgcn_rsqf(x); }
__device__ __forceinline__ float sigmoidf_(float x) { return frcp(1.f + fexp2(-x * LOG2E)); }
__device__ __forceinline__ float siluf_(float x) { return x * sigmoidf_(x); }
__device__ __forceinline__ float gelu_tanh(float x) { const float u = x + 0.044715f * x * x * x; return x * frcp(1.f + fexp2(-2.3022082f * u)); }
__device__ __forceinline__ float logsigmoidf_(float x) { return fminf(x, 0.f) - LN2 * flog2(1.f + fexp2(-fabsf(x) * LOG2E)); }
typedef float f32x2 __attribute__((ext_vector_type(2)));
__device__ __forceinline__ f32x2 exp2_2(f32x2 t) { f32x2 e; e.x = fexp2(t.x); e.y = fexp2(t.y); return e; }
__device__ __forceinline__ f32x2 rcp_2(f32x2 d) { f32x2 r; r.x = frcp(d.x); r.y = frcp(d.y); return r; }
__device__ __forceinline__ f32x2 swiglu2(f32x2 g, f32x2 u, float na, float rs2) { const f32x2 r = rcp_2(exp2_2(g * na) + 1.0f); return (g * u) * (r * rs2); }
__device__ __forceinline__ f32x2 sigmoid2(f32x2 x, float na) { return rcp_2(exp2_2(x * na) + 1.0f); }
__device__ __forceinline__ f32x2 gelu2(f32x2 x, float rs) { const f32x2 v = x * rs; const f32x2 w = v * (v * v * 0.044715f + 1.0f); return v * rcp_2(exp2_2(w * -2.3022082f) + 1.0f); }
typedef unsigned long long u64;
__device__ __forceinline__ float rstd_of(u64 ssq) { return frsq((float)ssq * (1.0f / (2048.0f * 16777216.0f)) + EPS); }
__device__ __forceinline__ u64 ssq_fix(float s) { return (u64)__float2ull_rn(s * 16777216.0f); }

namespace pg8 {
constexpr int BM = 256, BK = 64, HALF = 128, HTB = HALF * BK * 2, STAGE_BYTES = 8 * HTB, NXCD = 8, WGM = 8;
__host__ __device__ __forceinline__ int lds_byte(int r, int c) { const int st = (r >> 4) * 2 + (c >> 5), rr = r & 15, cc = c & 31, ob = rr * 64 + cc * 2; return st * 1024 + (ob ^ (((ob >> 9) & 1) << 5)); }
__host__ __device__ __forceinline__ void stage_rc(int b, int& R, int& C) { const int st = b / 1024, sb = b % 1024, swz = sb ^ (((sb >> 9) & 1) << 5); R = (st >> 1) * 16 + swz / 64; C = (st & 1) * 32 + (swz % 64) / 2; }
__host__ __device__ __forceinline__ int perm32(int rho) { const int n = rho >> 4, i = rho & 15; return 8 * (i >> 2) + 4 * n + (i & 3); }

struct Unit { int pm, pn; };
struct Gemm { const bf16_t* A; const bf16_t* Bt; int M, N, K; };

struct StaticOrder {
    int nM, nN, nwg, G, c;
    __device__ void init(int M, int N, int G_, int c_) { nM = M / BM; nN = N / BM; nwg = nM * nN; G = G_; c = c_; }
    __device__ bool next(int i, Unit& u) const {
        const long L = (long)i * G + c; if (L >= nwg) return false;
        int wgid = (int)L; { const int q = nwg / NXCD, r = nwg % NXCD, xcd = wgid % NXCD, off = wgid / NXCD; wgid = (xcd < r ? xcd * (q + 1) : r * (q + 1) + (xcd - r) * q) + off; }
        const int nig = WGM * nN, gid = wgid / nig, fm = gid * WGM, gsz = (nM - fm) < WGM ? (nM - fm) : WGM;
        u.pm = fm + ((wgid % nig) % gsz); u.pn = (wgid % nig) / gsz; return true;
    }
};

template <class Epi, class Sched, bool ALIGN_EPI = true, bool SP2 = true>
__device__ __forceinline__ void gemm_phase(LAS unsigned char* lds, const Gemm g, const Sched& S, const Epi& E) {
    int tid_ = threadIdx.x; asm volatile("" : "+v"(tid_));
    const int tid = tid_, wid = __builtin_amdgcn_readfirstlane(tid >> 6), lane = tid & 63, wr = wid >> 2, wc = wid & 3, fr = lane & 15, fq = lane >> 4;
    const int K = g.K, nt = K / BK;
    unsigned voffA[2], voffB[2];
#pragma unroll
    for (int i = 0; i < 2; ++i) { int R, C; stage_rc(tid * 16 + i * 8192, R, C); const int Rb = (R & ~31) + perm32(R & 31);
        voffA[i] = (unsigned)(R * K + C) * 2u; voffB[i] = (unsigned)(Rb * K + C) * 2u; }
    const size_t kstep = (size_t)(BK * 2);
    const size_t hstep = (size_t)HALF * K * 2;
    const size_t tstep = 2 * hstep;
    const unsigned ldsw = (unsigned)wid * 1024u;
    const int aoff = lds_byte(wr * 64 + fr, fq * 8), boff = lds_byte(wc * 32 + fr, fq * 8);
#define PG8_SA(b, h) (((b) * 2 + (h)) * HTB)
#define PG8_SB(b, h) ((4 + (b) * 2 + (h)) * HTB)
#define PG8_STAGE(bufoff, gbase, voff) do { _Pragma("unroll") for (int _i = 0; _i < 2; ++_i) \
        __builtin_amdgcn_global_load_lds((const unsigned*)((const char*)(gbase) + (voff)[_i]), (LAS unsigned*)(lds + (bufoff) + ldsw + _i * 8192), 16, 0, 0); } while (0)
#define PG8_LDA(dst, b, h) do { _Pragma("unroll") for (int m = 0; m < 4; ++m) _Pragma("unroll") for (int k = 0; k < 2; ++k) dst[m][k] = *(const LAS bf16x8*)(lds + PG8_SA(b, h) + aoff + m * 2048 + k * 1024); } while (0)
#define PG8_LDB(dst, b, h) do { _Pragma("unroll") for (int n = 0; n < 2; ++n) _Pragma("unroll") for (int k = 0; k < 2; ++k) dst[n][k] = *(const LAS bf16x8*)(lds + PG8_SB(b, h) + boff + n * 2048 + k * 1024); } while (0)
#define PG8_MMA(ai, bj, At, Bt) do { __builtin_amdgcn_s_setprio(1); _Pragma("unroll") for (int m = 0; m < 4; ++m) _Pragma("unroll") for (int n = 0; n < 2; ++n) _Pragma("unroll") for (int k = 0; k < 2; ++k) \
        acc[ai][bj][m][n] = __builtin_amdgcn_mfma_f32_16x16x32_bf16(Bt[n][k], At[m][k], acc[ai][bj][m][n], 0, 0, 0); __builtin_amdgcn_s_setprio(0); } while (0)
#define PG8_WAIT_V(n) asm volatile("s_waitcnt vmcnt(" #n ")" ::: "memory")
#define PG8_WAIT_L(n) asm volatile("s_waitcnt lgkmcnt(" #n ")" ::: "memory")
#define PG8_BAR __builtin_amdgcn_s_barrier()
#define PG8_SCHED __builtin_amdgcn_sched_barrier(0)
    Unit cur, nxt; int ui = 0;
    if (!S.next(0, cur)) return;
    f32x4 acc[2][2][4][2];
#pragma unroll
    for (int a = 0; a < 2; ++a)
#pragma unroll
        for (int b = 0; b < 2; ++b)
#pragma unroll
            for (int m = 0; m < 4; ++m)
#pragma unroll
                for (int n = 0; n < 2; ++n) acc[a][b][m][n] = (f32x4){0.f, 0.f, 0.f, 0.f};
    bf16x8 At[4][2], B0[2][2], B1[2][2];
    const char* cA = (const char*)g.A + (size_t)cur.pm * tstep; const char* cB = (const char*)g.Bt + (size_t)cur.pn * tstep;
    if constexpr (SP2) {
        PG8_STAGE(PG8_SB(0, 0), cB, voffB); PG8_STAGE(PG8_SB(0, 1), cB + hstep, voffB); PG8_STAGE(PG8_SA(0, 0), cA, voffA); PG8_STAGE(PG8_SA(0, 1), cA + hstep, voffA);
        if (wr == 1) PG8_BAR;
        PG8_WAIT_V(2); PG8_BAR;
        PG8_STAGE(PG8_SB(1, 0), cB + kstep, voffB); PG8_STAGE(PG8_SA(1, 0), cA + kstep, voffA); PG8_STAGE(PG8_SB(1, 1), cB + hstep + kstep, voffB);
        PG8_WAIT_V(6); PG8_BAR;
    } else {
        PG8_STAGE(PG8_SB(0, 0), cB, voffB); PG8_STAGE(PG8_SA(0, 0), cA, voffA); PG8_STAGE(PG8_SB(0, 1), cB + hstep, voffB); PG8_STAGE(PG8_SA(0, 1), cA + hstep, voffA);
        if (wr == 1) PG8_BAR;
        PG8_WAIT_V(4); PG8_BAR;
        PG8_STAGE(PG8_SB(1, 0), cB + kstep, voffB); PG8_STAGE(PG8_SA(1, 0), cA + kstep, voffA); PG8_STAGE(PG8_SB(1, 1), cB + hstep + kstep, voffB);
        PG8_WAIT_V(6); PG8_BAR;
    }
    for (;;) {
        const bool has_next = S.next(ui + 1, nxt);
        const char* nA = has_next ? (const char*)g.A + (size_t)nxt.pm * tstep : cA; const char* nB = has_next ? (const char*)g.Bt + (size_t)nxt.pn * tstep : cB;
        for (int t = 0; t < nt; t += 2) {
            const bool last = (t == nt - 2);
            const char* a1 = cA + (size_t)(t + 1) * kstep;
            const char* a2 = last ? nA : cA + (size_t)(t + 2) * kstep; const char* b2 = last ? nB : cB + (size_t)(t + 2) * kstep;
            const char* a3 = a2 + kstep; const char* b3 = b2 + kstep;
            if constexpr (SP2) {
            PG8_LDB(B0, 0, 0); PG8_LDB(B1, 0, 1); PG8_SCHED; PG8_LDA(At, 0, 0); PG8_STAGE(PG8_SA(1, 1), a1 + hstep, voffA);
            PG8_WAIT_V(8); PG8_WAIT_L(0); PG8_BAR; PG8_MMA(0, 0, At, B0); PG8_MMA(0, 1, At, B1); PG8_BAR; PG8_SCHED;
            PG8_LDA(At, 0, 1); PG8_STAGE(PG8_SB(0, 0), b2, voffB); PG8_STAGE(PG8_SB(0, 1), b2 + hstep, voffB); PG8_STAGE(PG8_SA(0, 0), a2, voffA);
            PG8_WAIT_V(8); PG8_WAIT_L(0); PG8_BAR; PG8_MMA(1, 0, At, B0); PG8_MMA(1, 1, At, B1); PG8_BAR; PG8_SCHED;
            PG8_LDB(B0, 1, 0); PG8_LDB(B1, 1, 1); PG8_SCHED; PG8_LDA(At, 1, 0); PG8_STAGE(PG8_SA(0, 1), a2 + hstep, voffA);
            PG8_WAIT_V(8); PG8_WAIT_L(0); PG8_BAR; PG8_MMA(0, 0, At, B0); PG8_MMA(0, 1, At, B1); PG8_BAR; PG8_SCHED;
            PG8_LDA(At, 1, 1); PG8_STAGE(PG8_SB(1, 0), b3, voffB); PG8_STAGE(PG8_SB(1, 1), b3 + hstep, voffB); PG8_STAGE(PG8_SA(1, 0), a3, voffA);
            PG8_WAIT_V(8); PG8_WAIT_L(0); PG8_BAR; PG8_MMA(1, 0, At, B0); PG8_MMA(1, 1, At, B1); PG8_BAR; PG8_SCHED;
            } else {
            PG8_LDB(B0, 0, 0); PG8_SCHED; PG8_LDA(At, 0, 0); PG8_STAGE(PG8_SA(1, 1), a1 + hstep, voffA);
            PG8_WAIT_L(8); PG8_BAR; PG8_WAIT_L(0); PG8_MMA(0, 0, At, B0); PG8_BAR; PG8_SCHED;
            PG8_LDB(B1, 0, 1); PG8_STAGE(PG8_SB(0, 0), b2, voffB);
            PG8_BAR; PG8_WAIT_L(0); PG8_MMA(0, 1, At, B1); PG8_BAR;
            PG8_LDA(At, 0, 1); PG8_STAGE(PG8_SA(0, 0), a2, voffA);
            PG8_BAR; PG8_WAIT_L(0); PG8_MMA(1, 0, At, B0); PG8_BAR; PG8_SCHED;
            PG8_STAGE(PG8_SB(0, 1), b2 + hstep, voffB);
            PG8_WAIT_V(6); PG8_BAR; PG8_MMA(1, 1, At, B1); PG8_BAR;
            PG8_LDB(B0, 1, 0); PG8_SCHED; PG8_LDA(At, 1, 0); PG8_STAGE(PG8_SA(0, 1), a2 + hstep, voffA);
            PG8_WAIT_L(8); PG8_BAR; PG8_WAIT_L(0); PG8_MMA(0, 0, At, B0); PG8_BAR; PG8_SCHED;
            PG8_LDB(B1, 1, 1); PG8_STAGE(PG8_SB(1, 0), b3, voffB);
            PG8_BAR; PG8_WAIT_L(0); PG8_MMA(0, 1, At, B1); PG8_BAR;
            PG8_LDA(At, 1, 1); PG8_STAGE(PG8_SA(1, 0), a3, voffA);
            PG8_BAR; PG8_WAIT_L(0); PG8_MMA(1, 0, At, B0); PG8_BAR; PG8_SCHED;
            PG8_STAGE(PG8_SB(1, 1), b3 + hstep, voffB);
            PG8_WAIT_V(6); PG8_BAR; PG8_MMA(1, 1, At, B1); PG8_BAR;
            }
        }
        if constexpr (ALIGN_EPI) { if (wr == 0) PG8_BAR; }
        E(acc, cur, wr, wc, fr, fq);
        if (!has_next) break;
#pragma unroll
        for (int a = 0; a < 2; ++a)
#pragma unroll
            for (int b = 0; b < 2; ++b)
#pragma unroll
                for (int m = 0; m < 4; ++m)
#pragma unroll
                    for (int n = 0; n < 2; ++n) acc[a][b][m][n] = (f32x4){0.f, 0.f, 0.f, 0.f};
        cur = nxt; cA = nA; cB = nB; ++ui;
        if constexpr (ALIGN_EPI) { if (wr == 1) PG8_BAR; }
    }
    PG8_WAIT_V(0);
    if constexpr (!ALIGN_EPI) { if (wr == 0) PG8_BAR; }
    PG8_BAR;
#undef PG8_SA
#undef PG8_SB
#undef PG8_STAGE
#undef PG8_LDA
#undef PG8_LDB
#undef PG8_MMA
#undef PG8_WAIT_V
#undef PG8_WAIT_L
#undef PG8_BAR
#undef PG8_SCHED
}

typedef f32x4 Acc[2][2][4][2];

struct EpiSwiGLU {
    bf16_t* O; const u64* ssq;
    __device__ __forceinline__ void operator()(const Acc& acc, const Unit& u, int wr, int wc, int fr, int fq) const {
        const int row0 = u.pm * BM + wr * 64 + fr, col0 = u.pn * 128 + wc * 32 + 8 * fq;
        float rsv[2][4];
#pragma unroll
        for (int ai = 0; ai < 2; ++ai)
#pragma unroll
            for (int m = 0; m < 4; ++m) rsv[ai][m] = rstd_of(ssq[row0 + ai * HALF + m * 16]);
#pragma unroll
        for (int ai = 0; ai < 2; ++ai)
#pragma unroll
            for (int m = 0; m < 4; ++m) {
                asm volatile("" ::: "memory");
                const int r = row0 + ai * HALF + m * 16; const float rs = rsv[ai][m]; const float na = -rs * LOG2E, rs2 = rs * rs;
                const f32x4 g0 = acc[ai][0][m][0], g1 = acc[ai][0][m][1], u0 = acc[ai][1][m][0], u1 = acc[ai][1][m][1];
                const f32x2 oa = swiglu2((f32x2){g0[0], g0[1]}, (f32x2){u0[0], u0[1]}, na, rs2), ob = swiglu2((f32x2){g0[2], g0[3]}, (f32x2){u0[2], u0[3]}, na, rs2);
                const f32x2 oc = swiglu2((f32x2){g1[0], g1[1]}, (f32x2){u1[0], u1[1]}, na, rs2), od = swiglu2((f32x2){g1[2], g1[3]}, (f32x2){u1[2], u1[3]}, na, rs2);
                u32x4 w; w.x = cvt_pk_bf16(oa.x, oa.y); w.y = cvt_pk_bf16(ob.x, ob.y); w.z = cvt_pk_bf16(oc.x, oc.y); w.w = cvt_pk_bf16(od.x, od.y);
                *(u32x4*)(O + (size_t)r * DFF + col0) = w;
            }
    }
};

struct EpiResid {
    const float* Hsrc; float* Hdst; bf16_t* HB; u64* ssq_out; int dry;
    __device__ __forceinline__ void operator()(const Acc& acc, const Unit& u, int wr, int wc, int fr, int fq) const {
        const int row0 = u.pm * BM + wr * 64 + fr, col0 = u.pn * BM + wc * 32 + 8 * fq;
#pragma unroll
        for (int ai = 0; ai < 2; ++ai)
#pragma unroll
            for (int m = 0; m < 4; ++m) {
                if ((m & 1) == 0) asm volatile("" ::: "memory");
                const int r = row0 + ai * HALF + m * 16; float part = 0.f;
#pragma unroll
                for (int bj = 0; bj < 2; ++bj) {
                    const size_t off = (size_t)r * D + col0 + bj * HALF;
                    const f32x4 h0 = *(const f32x4*)(Hsrc + off), h1 = *(const f32x4*)(Hsrc + off + 4);
                    const f32x4 v0 = h0 + acc[ai][bj][m][0], v1 = h1 + acc[ai][bj][m][1];
                    if (!dry) { *(f32x4*)(Hdst + off) = v0; *(f32x4*)(Hdst + off + 4) = v1; }
                    u32x4 w; w.x = cvt_pk_bf16(v0[0], v0[1]); w.y = cvt_pk_bf16(v0[2], v0[3]); w.z = cvt_pk_bf16(v1[0], v1[1]); w.w = cvt_pk_bf16(v1[2], v1[3]);
                    if (!dry) *(u32x4*)(HB + off) = w;
                    part += v0[0] * v0[0] + v0[1] * v0[1] + v0[2] * v0[2] + v0[3] * v0[3] + v1[0] * v1[0] + v1[1] * v1[1] + v1[2] * v1[2] + v1[3] * v1[3];
                }
                part += __shfl_xor(part, 16); part += __shfl_xor(part, 32);
                if (fq == 0 && !dry) atomicAdd(ssq_out + r, ssq_fix(part));
            }
    }
};

struct EpiRowScale {
    bf16_t* O; int ldc; const u64* ssq;
    __device__ __forceinline__ void operator()(const Acc& acc, const Unit& u, int wr, int wc, int fr, int fq) const {
        const int row0 = u.pm * BM + wr * 64 + fr, col0 = u.pn * BM + wc * 32 + 8 * fq;
        float rsv[2][4];
#pragma unroll
        for (int ai = 0; ai < 2; ++ai)
#pragma unroll
            for (int m = 0; m < 4; ++m) rsv[ai][m] = rstd_of(ssq[row0 + ai * HALF + m * 16]);
#pragma unroll
        for (int ai = 0; ai < 2; ++ai)
#pragma unroll
            for (int m = 0; m < 4; ++m) {
                asm volatile("" ::: "memory");
                const int r = row0 + ai * HALF + m * 16; const float rs = rsv[ai][m];
#pragma unroll
                for (int bj = 0; bj < 2; ++bj) {
                    const f32x4 v0 = acc[ai][bj][m][0] * rs, v1 = acc[ai][bj][m][1] * rs;
                    u32x4 w; w.x = cvt_pk_bf16(v0[0], v0[1]); w.y = cvt_pk_bf16(v0[2], v0[3]); w.z = cvt_pk_bf16(v1[0], v1[1]); w.w = cvt_pk_bf16(v1[2], v1[3]);
                    *(u32x4*)(O + (size_t)r * ldc + col0 + bj * HALF) = w;
                }
            }
    }
};

struct EpiWin {
    unsigned char* ws; const u64* ssq;
    __device__ __forceinline__ void operator()(const Acc& acc, const Unit& u, int wr, int wc, int fr, int fq) const {
        const int pn = u.pn; const int row0 = u.pm * BM + wr * 64 + fr;
        bf16_t* base; int ldc, colt, act = 0;
        if (pn < 4) { base = (bf16_t*)(ws + Z_U); ldc = 1024; colt = pn * 256; act = 1; }
        else if (pn < 8) { base = (bf16_t*)(ws + Z_V); ldc = 1024; colt = (pn - 4) * 256; act = 1; }
        else if (pn < 12) { base = (bf16_t*)(ws + Z_FQ); ldc = 1024; colt = (pn - 8) * 256; }
        else if (pn < 16) { base = (bf16_t*)(ws + Z_FK); ldc = 1024; colt = (pn - 12) * 256; }
        else if (pn < 20) { base = (bf16_t*)(ws + Z_FV); ldc = 1024; colt = (pn - 16) * 256; }
        else if (pn < 22) { base = (bf16_t*)(ws + Z_GQ); ldc = 512; colt = (pn - 20) * 256; }
        else if (pn < 24) { base = (bf16_t*)(ws + Z_GK); ldc = 512; colt = (pn - 22) * 256; }
        else if (pn < 28) { base = (bf16_t*)(ws + Z_GV); ldc = 1024; colt = (pn - 24) * 256; }
        else if (pn < 32) { base = (bf16_t*)(ws + Z_GR); ldc = 1024; colt = (pn - 28) * 256; }
        else { base = (bf16_t*)(ws + Z_GATES); ldc = 6144; colt = (pn - 32) * 256; act = 2; }
        const int col0 = colt + wc * 32 + 8 * fq;
        float rsv[2][4];
#pragma unroll
        for (int ai = 0; ai < 2; ++ai)
#pragma unroll
            for (int m = 0; m < 4; ++m) rsv[ai][m] = rstd_of(ssq[row0 + ai * HALF + m * 16]);
#pragma unroll
        for (int ai = 0; ai < 2; ++ai)
#pragma unroll
            for (int m = 0; m < 4; ++m) {
                asm volatile("" ::: "memory");
                const int r = row0 + ai * HALF + m * 16; const float rs = rsv[ai][m];
#pragma unroll
                for (int bj = 0; bj < 2; ++bj) {
                    const f32x4 x0 = acc[ai][bj][m][0], x1 = acc[ai][bj][m][1];
                    f32x2 a, b, c, d;
                    if (act == 1) { a = gelu2((f32x2){x0[0], x0[1]}, rs); b = gelu2((f32x2){x0[2], x0[3]}, rs); c = gelu2((f32x2){x1[0], x1[1]}, rs); d = gelu2((f32x2){x1[2], x1[3]}, rs); }
                    else if (act == 2) { const float na = -rs * LOG2E; a = sigmoid2((f32x2){x0[0], x0[1]}, na); b = sigmoid2((f32x2){x0[2], x0[3]}, na); c = sigmoid2((f32x2){x1[0], x1[1]}, na); d = sigmoid2((f32x2){x1[2], x1[3]}, na); }
                    else { a = (f32x2){x0[0], x0[1]} * rs; b = (f32x2){x0[2], x0[3]} * rs; c = (f32x2){x1[0], x1[1]} * rs; d = (f32x2){x1[2], x1[3]} * rs; }
                    u32x4 w; w.x = cvt_pk_bf16(a.x, a.y); w.y = cvt_pk_bf16(b.x, b.y); w.z = cvt_pk_bf16(c.x, c.y); w.w = cvt_pk_bf16(d.x, d.y);
                    *(u32x4*)(base + (size_t)r * ldc + col0 + bj * HALF) = w;
                }
            }
    }
};

struct EpiBranch {
    const bf16_t* gates; float* M32; bf16_t* MB; bf16_t* MA; int br;
    __device__ __forceinline__ void operator()(const Acc& acc, const Unit& u, int wr, int wc, int fr, int fq) const {
        const int row0 = u.pm * BM + wr * 64 + fr, col0 = u.pn * BM + wc * 32 + 8 * fq;
#pragma unroll
        for (int ai = 0; ai < 2; ++ai)
#pragma unroll
            for (int m = 0; m < 4; ++m) {
                if ((m & 1) == 0) asm volatile("" ::: "memory");
                const int r = row0 + ai * HALF + m * 16;
#pragma unroll
                for (int bj = 0; bj < 2; ++bj) {
                    const int c = col0 + bj * HALF; const size_t off = (size_t)r * D + c;
                    const u32x4 gw = *(const u32x4*)(gates + (size_t)r * 6144 + br * D + c);
                    f32x4 v0, v1;
                    v0[0] = acc[ai][bj][m][0][0] * bflo(gw.x); v0[1] = acc[ai][bj][m][0][1] * bfhi(gw.x); v0[2] = acc[ai][bj][m][0][2] * bflo(gw.y); v0[3] = acc[ai][bj][m][0][3] * bfhi(gw.y);
                    v1[0] = acc[ai][bj][m][1][0] * bflo(gw.z); v1[1] = acc[ai][bj][m][1][1] * bfhi(gw.z); v1[2] = acc[ai][bj][m][1][2] * bflo(gw.w); v1[3] = acc[ai][bj][m][1][3] * bfhi(gw.w);
                    if (br == 1) { const u32x4 ma = *(const u32x4*)(MA + off);
                        v0[0] += bflo(ma.x); v0[1] += bfhi(ma.x); v0[2] += bflo(ma.y); v0[3] += bfhi(ma.y); v1[0] += bflo(ma.z); v1[1] += bfhi(ma.z); v1[2] += bflo(ma.w); v1[3] += bfhi(ma.w); }
                    if (br == 2) { v0 += *(const f32x4*)(M32 + off); v1 += *(const f32x4*)(M32 + off + 4); }
                    if (br == 1) { *(f32x4*)(M32 + off) = v0; *(f32x4*)(M32 + off + 4) = v1; }
                    else { u32x4 w; w.x = cvt_pk_bf16(v0[0], v0[1]); w.y = cvt_pk_bf16(v0[2], v0[3]); w.z = cvt_pk_bf16(v1[0], v1[1]); w.w = cvt_pk_bf16(v1[2], v1[3]);
                        *(u32x4*)((br == 0 ? MA : MB) + off) = w; }
                }
            }
    }
};
}

__device__ __forceinline__ f32x4 mfma16(bf16x8 a, bf16x8 b, f32x4 c) { return __builtin_amdgcn_mfma_f32_16x16x32_bf16(a, b, c, 0, 0, 0); }
__device__ __forceinline__ bf16x8 mk8(unsigned a, unsigned b, unsigned c, unsigned d) { u32x4 v; v.x = a; v.y = b; v.z = c; v.w = d; return __builtin_bit_cast(bf16x8, v); }
__device__ __forceinline__ float wave_sum(float v) {
#pragma unroll
    for (int d = 1; d < 64; d <<= 1) v += __shfl_xor(v, d);
    return v;
}

template <int KIND> __device__ __forceinline__ int map_col(int n, float& sc) {
    sc = 1.f;
    if (KIND == 0) return n;
    if (KIND == 1) { const int pn = n >> 8, r = n & 255; return (r < 128) ? (pn * 128 + r) : (DFF + pn * 128 + (r - 128)); }
    if (n < 2048) return n;
    if (n < 3072) { sc = 0.08838834764831845f * LOG2E; return n; }
    if (n < 5120) return n;
    if (n < 5632) { sc = 0.08838834764831845f; return 5128 + (n - 5120); }
    if (n < 6144) return 5640 + (n - 5632);
    if (n < 7168) return 6152 + (n - 6144);
    if (n < 8192) return 7192 + (n - 7168);
    if (n < 14336) return 8216 + (n - 8192);
    n -= 14336;
    if (n < 8) return 5120 + n;
    if (n < 24) return 7176 + (n - 8);
    return -1;
}

template <int KIND>
__device__ __forceinline__ void prep_job(LAS unsigned char* lds, const float* W, int K, int Nsrc, bf16_t* Bt, int Ndst, const float* gain, float scale, int& base, int G, int w) {
    int tid_ = threadIdx.x; asm volatile("" : "+v"(tid_));
    const int tid = tid_;
    const int ntk = K / 64, ntiles = (Ndst / 256) * ntk;
    asm volatile("" : "+s"(w));
    const int t0 = ((w - base) % G + G) % G;
    base += ntiles;
    LAS bf16_t* tl = (LAS bf16_t*)lds;
    const int n4 = (tid & 63) * 4, kk = tid >> 6;
    for (int t = t0; t < ntiles; t += G) {
        const int tn = t / ntk, tk = t - tn * ntk, n0 = tn * 256, k0 = tk * 64;
        float sc; const int src = map_col<KIND>(n0 + n4, sc); sc *= scale;
        f32x4 v[8];
#pragma unroll
        for (int i = 0; i < 8; ++i) v[i] = (src >= 0) ? __builtin_nontemporal_load((const f32x4*)(W + (size_t)(k0 + i * 8 + kk) * Nsrc + src)) : (f32x4){0.f, 0.f, 0.f, 0.f};
#pragma unroll
        for (int i = 0; i < 8; ++i) {
            const int k = i * 8 + kk; const float gs = sc * (gain ? gain[k0 + k] : 1.f);
            LAS unsigned* p = (LAS unsigned*)(tl + k * 258 + n4);
            p[0] = cvt_pk_bf16(v[i][0] * gs, v[i][1] * gs); p[1] = cvt_pk_bf16(v[i][2] * gs, v[i][3] * gs);
        }
        __syncthreads();
#pragma unroll
        for (int i = 0; i < 4; ++i) {
            const int ch = i * 512 + tid, n = ch >> 3, kc = (ch & 7) * 8;
            const LAS bf16_t* q = tl + kc * 258 + n;
            u32x4 d;
            d.x = (unsigned)q[0 * 258] | ((unsigned)q[1 * 258] << 16); d.y = (unsigned)q[2 * 258] | ((unsigned)q[3 * 258] << 16);
            d.z = (unsigned)q[4 * 258] | ((unsigned)q[5 * 258] << 16); d.w = (unsigned)q[6 * 258] | ((unsigned)q[7 * 258] << 16);
            *(u32x4*)(Bt + (size_t)(n0 + n) * K + k0 + kc) = d;
        }
        __syncthreads();
    }
}

__device__ __forceinline__ void rows_to_bf16(const float* X, bf16_t* XB, u64* ssq, int rows, int gw, int nw) {
    int tid_ = threadIdx.x; asm volatile("" : "+v"(tid_)); asm volatile("" : "+v"(gw));
    const int lane = tid_ & 63;
    for (int r = gw; r < rows; r += nw) {
        const float* xr = X + (size_t)r * D; bf16_t* br = XB + (size_t)r * D; float ss = 0.f;
#pragma unroll
        for (int i = 0; i < 8; ++i) {
            const f32x4 v = __builtin_nontemporal_load((const f32x4*)(xr + (i * 64 + lane) * 4));
            ss += v[0] * v[0] + v[1] * v[1] + v[2] * v[2] + v[3] * v[3];
            u32x2 w; w.x = cvt_pk_bf16(v[0], v[1]); w.y = cvt_pk_bf16(v[2], v[3]);
            *(u32x2*)(br + (i * 64 + lane) * 4) = w;
        }
        ss = wave_sum(ss);
        if (lane == 0) ssq[r] = ssq_fix(ss);
    }
}

__device__ __forceinline__ void narrow_cols_unit(LAS unsigned char* lds, int rb, const bf16_t* HB, const bf16_t* Btn, const u64* ssq, const float* b_f, float* LOGF, float* GA) {
    int tid_ = threadIdx.x; asm volatile("" : "+v"(tid_));
    const int tid = tid_, wid = __builtin_amdgcn_readfirstlane(tid >> 6), lane = tid & 63, fr = lane & 15, fq = lane >> 4, rg = wid & 3, kh = wid >> 2;
    const bf16_t* arow = HB + (size_t)(rb * 64 + rg * 16 + fr) * D + kh * 1024 + fq * 8;
    const bf16_t* b0 = Btn + (size_t)fr * D + kh * 1024 + fq * 8;
    const bf16_t* b1 = Btn + (size_t)(16 + fr) * D + kh * 1024 + fq * 8;
    f32x4 acc0 = (f32x4){0.f, 0.f, 0.f, 0.f}, acc1 = acc0;
#pragma unroll 8
    for (int ks = 0; ks < 32; ++ks) {
        const bf16x8 af = *(const bf16x8*)(arow + ks * 32), bf0 = *(const bf16x8*)(b0 + ks * 32), bf1 = *(const bf16x8*)(b1 + ks * 32);
        acc0 = mfma16(bf0, af, acc0); acc1 = mfma16(bf1, af, acc1);
    }
    LAS f32x4* red = (LAS f32x4*)lds;
    __syncthreads();
    if (kh == 1) { red[(rg * 2 + 0) * 64 + lane] = acc0; red[(rg * 2 + 1) * 64 + lane] = acc1; }
    __syncthreads();
    if (kh == 0) {
        acc0 += red[(rg * 2 + 0) * 64 + lane]; acc1 += red[(rg * 2 + 1) * 64 + lane];
        const int r = rb * 64 + rg * 16 + fr; const float rs = rstd_of(ssq[r]);
        if (fq < 2) {
            const f32x4 bf = *(const f32x4*)(b_f + fq * 4); f32x4 v;
#pragma unroll
            for (int e = 0; e < 4; ++e) v[e] = logsigmoidf_(acc0[e] * rs + bf[e]);
            *(f32x4*)(LOGF + (size_t)r * 8 + fq * 4) = v;
            *(f32x4*)(GA + (size_t)r * 16 + 8 + fq * 4) = acc1 * rs;
        } else {
            *(f32x4*)(GA + (size_t)r * 16 + (fq - 2) * 4) = acc0 * rs;
        }
    }
}

template <bool FOX>
__device__ __forceinline__ void attn_tile(LAS bf16_t* Ks, LAS bf16_t* Vt, LAS float* cum, int j, bool diag, int fr, int fq, const int (&qpos)[2], const float (&cq)[2],
                                          const bf16x8 (&qf)[2][4], f32x4 (&o)[2][8], float (&m_run)[2], float (&l_run)[2]) {
    f32x4 s[2][4];
#pragma unroll
    for (int mt = 0; mt < 4; ++mt) {
        s[0][mt] = (f32x4){0.f, 0.f, 0.f, 0.f}; s[1][mt] = (f32x4){0.f, 0.f, 0.f, 0.f};
#pragma unroll
        for (int ks = 0; ks < 4; ++ks) { const bf16x8 kf = *(const LAS bf16x8*)(Ks + (mt * 16 + fr) * 136 + ks * 32 + fq * 8); s[0][mt] = mfma16(kf, qf[0][ks], s[0][mt]); s[1][mt] = mfma16(kf, qf[1][ks], s[1][mt]); }
    }
    if (FOX) {
#pragma unroll
        for (int mt = 0; mt < 4; ++mt) { const f32x4 ck = *(const LAS f32x4*)(cum + j * 64 + mt * 16 + fq * 4);
#pragma unroll
            for (int e = 0; e < 4; ++e) { s[0][mt][e] += cq[0] - ck[e]; s[1][mt][e] += cq[1] - ck[e]; } }
        if (diag) {
#pragma unroll
            for (int g = 0; g < 2; ++g)
#pragma unroll
                for (int mt = 0; mt < 4; ++mt)
#pragma unroll
                    for (int e = 0; e < 4; ++e) if (j * 64 + mt * 16 + fq * 4 + e > qpos[g]) s[g][mt][e] = -INFINITY;
        }
    }
    bf16x8 pf[2][2];
#pragma unroll
    for (int g = 0; g < 2; ++g) {
        float mx = -INFINITY;
#pragma unroll
        for (int mt = 0; mt < 4; ++mt)
#pragma unroll
            for (int e = 0; e < 4; ++e) mx = fmaxf(mx, s[g][mt][e]);
        mx = fmaxf(mx, __shfl_xor(mx, 16)); mx = fmaxf(mx, __shfl_xor(mx, 32));
        const float m_new = fmaxf(m_run[g], mx);
        const float alpha = fexp2(m_run[g] - m_new);
        float ls = 0.f;
#pragma unroll
        for (int mt = 0; mt < 4; ++mt)
#pragma unroll
            for (int e = 0; e < 4; ++e) { const float p = fexp2(s[g][mt][e] - m_new); s[g][mt][e] = p; ls += p; }
        l_run[g] = l_run[g] * alpha + ls; m_run[g] = m_new;
#pragma unroll
        for (int i = 0; i < 8; ++i) o[g][i] *= alpha;
#pragma unroll
        for (int i = 0; i < 2; ++i) pf[g][i] = mk8(cvt_pk_bf16(s[g][2 * i][0], s[g][2 * i][1]), cvt_pk_bf16(s[g][2 * i][2], s[g][2 * i][3]), cvt_pk_bf16(s[g][2 * i + 1][0], s[g][2 * i + 1][1]), cvt_pk_bf16(s[g][2 * i + 1][2], s[g][2 * i + 1][3]));
    }
#pragma unroll
    for (int dt = 0; dt < 8; ++dt)
#pragma unroll
        for (int i = 0; i < 2; ++i) {
            const u32x2 lo = *(const LAS u32x2*)(Vt + (dt * 16 + fr) * 72 + i * 32 + fq * 4), hi2 = *(const LAS u32x2*)(Vt + (dt * 16 + fr) * 72 + i * 32 + 16 + fq * 4);
            const bf16x8 vf = mk8(lo.x, lo.y, hi2.x, hi2.y);
            o[0][dt] = mfma16(vf, pf[0][i], o[0][dt]); o[1][dt] = mfma16(vf, pf[1][i], o[1][dt]);
        }
}

template <bool FOX>
__device__ __forceinline__ void attn_unit(LAS unsigned char* lds, const bf16_t* Qp, int ldq, const bf16_t* Kp, const bf16_t* Vp, int ldkv, bf16_t* Op, int ldo,
                                          int ntiles  , int qpos0, const float* logf_bh, bool dry) {
    int tid_ = threadIdx.x; asm volatile("" : "+v"(tid_));
    const int tid = tid_, wid = __builtin_amdgcn_readfirstlane(tid >> 6), lane = tid & 63, fr = lane & 15, fq = lane >> 4;
    LAS bf16_t* Ks0 = (LAS bf16_t*)lds;
    LAS bf16_t* Vt0 = (LAS bf16_t*)(lds + 17408);
    LAS bf16_t* Ks1 = (LAS bf16_t*)(lds + 35840);
    LAS bf16_t* Vt1 = (LAS bf16_t*)(lds + 35840 + 17408);
    LAS float* cum = (LAS float*)(lds + 71680);
    LAS float* wsum = (LAS float*)(lds + 71680 + 8192);
    __syncthreads();
    if (FOX) {
        const int hi = ntiles * 64;
        float a0, a1, a2, a3;
        { const int i0 = 4 * tid; a0 = (i0 < hi) ? logf_bh[(size_t)i0 * 8] : 0.f; a1 = (i0 + 1 < hi) ? logf_bh[(size_t)(i0 + 1) * 8] : 0.f;
          a2 = (i0 + 2 < hi) ? logf_bh[(size_t)(i0 + 2) * 8] : 0.f; a3 = (i0 + 3 < hi) ? logf_bh[(size_t)(i0 + 3) * 8] : 0.f; }
        a1 += a0; a2 += a1; a3 += a2;
        float tot = a3;
#pragma unroll
        for (int d = 1; d < 64; d <<= 1) { const float t = __shfl_up(tot, d); if (lane >= d) tot += t; }
        if (lane == 63) wsum[wid] = tot;
        __syncthreads();
        float basep = 0.f;
        for (int w = 0; w < wid; ++w) basep += wsum[w];
        const float ex = basep + tot - a3;
        cum[4 * tid + 0] = (ex + a0) * LOG2E; cum[4 * tid + 1] = (ex + a1) * LOG2E; cum[4 * tid + 2] = (ex + a2) * LOG2E; cum[4 * tid + 3] = (ex + a3) * LOG2E;
        __syncthreads();
    }
    bf16x8 qf[2][4];
#pragma unroll
    for (int g = 0; g < 2; ++g) { const bf16_t* qrow = Qp + (size_t)(wid * 32 + g * 16 + fr) * ldq;
#pragma unroll
        for (int ks = 0; ks < 4; ++ks) qf[g][ks] = *(const bf16x8*)(qrow + ks * 32 + fq * 8); }
    int qpos[2]; qpos[0] = qpos0 + wid * 32 + fr; qpos[1] = qpos[0] + 16;
    float cq[2]; cq[0] = FOX ? cum[qpos[0]] : 0.f; cq[1] = FOX ? cum[qpos[1]] : 0.f;
    float m_run[2] = {-INFINITY, -INFINITY}, l_run[2] = {0.f, 0.f};
    f32x4 o[2][8];
#pragma unroll
    for (int i = 0; i < 8; ++i) { o[0][i] = (f32x4){0.f, 0.f, 0.f, 0.f}; o[1][i] = (f32x4){0.f, 0.f, 0.f, 0.f}; }
    const int wave_last = qpos0 + wid * 32 + 31;
    u32x4 kA[2], vA[2], kB[2], vB[2];
#define ATT_LOAD(kr, vr, j) do { _Pragma("unroll") for (int i = 0; i < 2; ++i) { const int ch = tid + i * 512; \
        kr[i] = *(const u32x4*)(Kp + (size_t)((j) * 64 + (ch >> 4)) * ldkv + (ch & 15) * 8); \
        vr[i] = *(const u32x4*)(Vp + (size_t)((j) * 64 + lane) * ldkv + (wid + 8 * i) * 8); } } while (0)
#define ATT_STAGE(Ks, Vt, kr, vr) do { _Pragma("unroll") for (int i = 0; i < 2; ++i) { const int ch = tid + i * 512; \
        *(LAS u32x4*)(Ks + (ch >> 4) * 136 + (ch & 15) * 8) = kr[i]; \
        LAS bf16_t* vp = Vt + ((wid + 8 * i) * 8) * 72 + lane; \
        vp[0 * 72] = (bf16_t)(vr[i].x & 0xffffu); vp[1 * 72] = (bf16_t)(vr[i].x >> 16); vp[2 * 72] = (bf16_t)(vr[i].y & 0xffffu); vp[3 * 72] = (bf16_t)(vr[i].y >> 16); \
        vp[4 * 72] = (bf16_t)(vr[i].z & 0xffffu); vp[5 * 72] = (bf16_t)(vr[i].z >> 16); vp[6 * 72] = (bf16_t)(vr[i].w & 0xffffu); vp[7 * 72] = (bf16_t)(vr[i].w >> 16); } } while (0)
    ATT_LOAD(kA, vA, 0); ATT_LOAD(kB, vB, 1);
    ATT_STAGE(Ks0, Vt0, kA, vA);
    if (2 < ntiles) ATT_LOAD(kA, vA, 2);
    __syncthreads();
    for (int j = 0; j < ntiles; j += 2) {
        ATT_STAGE(Ks1, Vt1, kB, vB);
        if (j + 3 < ntiles) ATT_LOAD(kB, vB, j + 3);
        if (!FOX || j * 64 <= wave_last) attn_tile<FOX>(Ks0, Vt0, cum, j, FOX && (j >= ntiles - 4), fr, fq, qpos, cq, qf, o, m_run, l_run);
        __syncthreads();
        if (j + 2 < ntiles) { ATT_STAGE(Ks0, Vt0, kA, vA); }
        if (j + 4 < ntiles) ATT_LOAD(kA, vA, j + 4);
        if (!FOX || (j + 1) * 64 <= wave_last) attn_tile<FOX>(Ks1, Vt1, cum, j + 1, FOX && (j + 1 >= ntiles - 4), fr, fq, qpos, cq, qf, o, m_run, l_run);
        __syncthreads();
    }
#undef ATT_LOAD
#undef ATT_STAGE
#pragma unroll
    for (int g = 0; g < 2; ++g) {
        float l = l_run[g]; l += __shfl_xor(l, 16); l += __shfl_xor(l, 32);
        const float inv = frcp(l);
        bf16_t* orow = Op + (size_t)(wid * 32 + g * 16 + fr) * ldo + fq * 4;
#pragma unroll
        for (int dt = 0; dt < 8; ++dt) { u32x2 w; w.x = cvt_pk_bf16(o[g][dt][0] * inv, o[g][dt][1] * inv); w.y = cvt_pk_bf16(o[g][dt][2] * inv, o[g][dt][3] * inv); if (!dry) *(u32x2*)(orow + dt * 16) = w; }
    }
}

__device__ __forceinline__ void sgu_unit(LAS unsigned char* lds, int b, int n, int g, const bf16_t* V, bf16_t* U, const float* ln_g, const float* ln_b, const float* w_s, const float* b_s, bool dry) {
    int tid_ = threadIdx.x; asm volatile("" : "+v"(tid_));
    const int tid = tid_, wid = tid >> 6, lane = tid & 63, fr = lane & 15, fq = lane >> 4;
    LAS bf16_t* vt = (LAS bf16_t*)lds;
    LAS float* st = (LAS float*)(lds + 69632);
    const int r0 = b * SEQ + n * 128;
    __syncthreads();
    for (int rr = 0; rr < 16; ++rr) {
        const int s = wid * 16 + rr;
        const u32x2 raw = *(const u32x2*)(V + (size_t)(r0 + s) * 1024 + g * 256 + lane * 4);
        const float x0 = bflo(raw.x), x1 = bfhi(raw.x), x2 = bflo(raw.y), x3 = bfhi(raw.y);
        const float mean = wave_sum(x0 + x1 + x2 + x3) * (1.f / 256.f);
        const float d0 = x0 - mean, d1 = x1 - mean, d2 = x2 - mean, d3 = x3 - mean;
        const float var = wave_sum(d0 * d0 + d1 * d1 + d2 * d2 + d3 * d3) * (1.f / 256.f);
        if (lane == 0) { st[2 * s] = mean; st[2 * s + 1] = frsq(var + EPS); }
    }
    __syncthreads();
    {
        const int s = tid & 127, cg0 = (tid >> 7) * 64;
        const float mean = st[2 * s], rstd = st[2 * s + 1];
        const bf16_t* vrow = V + (size_t)(r0 + s) * 1024 + g * 256 + cg0;
#pragma unroll
        for (int i = 0; i < 8; ++i) {
            const u32x4 raw = *(const u32x4*)(vrow + i * 8);
            const f32x4 g0 = *(const f32x4*)(ln_g + g * 256 + cg0 + i * 8), g1 = *(const f32x4*)(ln_g + g * 256 + cg0 + i * 8 + 4);
            const f32x4 b0 = *(const f32x4*)(ln_b + g * 256 + cg0 + i * 8), b1 = *(const f32x4*)(ln_b + g * 256 + cg0 + i * 8 + 4);
            LAS bf16_t* p = vt + (cg0 + i * 8) * 136 + s;
            p[0 * 136] = f2bf((bflo(raw.x) - mean) * rstd * g0[0] + b0[0]); p[1 * 136] = f2bf((bfhi(raw.x) - mean) * rstd * g0[1] + b0[1]);
            p[2 * 136] = f2bf((bflo(raw.y) - mean) * rstd * g0[2] + b0[2]); p[3 * 136] = f2bf((bfhi(raw.y) - mean) * rstd * g0[3] + b0[3]);
            p[4 * 136] = f2bf((bflo(raw.z) - mean) * rstd * g1[0] + b1[0]); p[5 * 136] = f2bf((bfhi(raw.z) - mean) * rstd * g1[1] + b1[1]);
            p[6 * 136] = f2bf((bflo(raw.w) - mean) * rstd * g1[2] + b1[2]); p[7 * 136] = f2bf((bfhi(raw.w) - mean) * rstd * g1[3] + b1[3]);
        }
    }
    __syncthreads();
    f32x4 acc[16];
#pragma unroll
    for (int i = 0; i < 16; ++i) acc[i] = (f32x4){0.f, 0.f, 0.f, 0.f};
    const int t = 16 * wid + fr;
    const int nks = (16 * wid + 15) / 32 + 1;
    for (int ks = 0; ks < nks; ++ks) {
        const float* wp = w_s + ((size_t)g * 128 + t) * 128 + ks * 32 + fq * 8;
        f32x4 w0 = *(const f32x4*)wp, w1 = *(const f32x4*)(wp + 4);
        const int sb = ks * 32 + fq * 8;
#pragma unroll
        for (int e = 0; e < 4; ++e) { if (sb + e > t) w0[e] = 0.f; if (sb + 4 + e > t) w1[e] = 0.f; }
        const bf16x8 wf = mk8(cvt_pk_bf16(w0[0], w0[1]), cvt_pk_bf16(w0[2], w0[3]), cvt_pk_bf16(w1[0], w1[1]), cvt_pk_bf16(w1[2], w1[3]));
#pragma unroll
        for (int nt = 0; nt < 16; ++nt) { const bf16x8 vf = *(const LAS bf16x8*)(vt + (nt * 16 + fr) * 136 + ks * 32 + fq * 8); acc[nt] = mfma16(vf, wf, acc[nt]); }
    }
    const float bs = b_s[g * 128 + t];
    bf16_t* up = U + (size_t)(r0 + t) * 1024 + g * 256 + fq * 4;
#pragma unroll
    for (int nt = 0; nt < 16; ++nt) {
        const u32x2 uu = *(const u32x2*)(up + nt * 16);
        u32x2 w; w.x = cvt_pk_bf16(bflo(uu.x) * (acc[nt][0] + bs), bfhi(uu.x) * (acc[nt][1] + bs)); w.y = cvt_pk_bf16(bflo(uu.y) * (acc[nt][2] + bs), bfhi(uu.y) * (acc[nt][3] + bs));
        if (!dry) *(u32x2*)(up + nt * 16) = w;
    }
}

__device__ __forceinline__ void gla_pre_unit(LAS unsigned char* lds, int b, int h, int ci, unsigned char* ws, const float* w_gate, const float* b_gate) {
    int tid_ = threadIdx.x; asm volatile("" : "+v"(tid_));
    const int tid = tid_, wid = tid >> 6, lane = tid & 63, fr = lane & 15, fq = lane >> 4;
    LAS bf16_t* QT = (LAS bf16_t*)lds;
    LAS bf16_t* KT = (LAS bf16_t*)(lds + 17408);
    LAS bf16_t* QD = (LAS bf16_t*)(lds + 34816);
    LAS bf16_t* KDT = (LAS bf16_t*)(lds + 52224);
    LAS bf16_t* VT = (LAS bf16_t*)(lds + 70656);
    LAS bf16_t* ATT = (LAS bf16_t*)(lds + 107520);
    LAS float* GAL = (LAS float*)(lds + 116736);
    LAS float* SEGTOT = (LAS float*)(lds + 120832);
    LAS float* BFIRST = (LAS float*)(lds + 122880);
    LAS float* DECAY = (LAS float*)(lds + 123392);
    const bf16_t* GQ = (const bf16_t*)(ws + Z_GQ); const bf16_t* GK = (const bf16_t*)(ws + Z_GK); const bf16_t* GV = (const bf16_t*)(ws + Z_GV);
    const float* GA = (const float*)(ws + WS_GA);
    const int unit = (b * 4 + h) * 32 + ci;
    bf16_t* OI = (bf16_t*)(ws + WS_OI) + (size_t)unit * 16384;
    bf16_t* UC = (bf16_t*)(ws + WS_UC) + (size_t)unit * 32768;
    bf16_t* QDF = (bf16_t*)(ws + WS_QDF) + (size_t)unit * 8192;
    float* DEC = (float*)(ws + WS_DEC) + (size_t)unit * 128;
    const int c = tid & 127, seg = tid >> 7;
    const int rc = b * SEQ + ci * 64;
    __syncthreads();
    if (tid < 256) *(LAS f32x4*)(GAL + tid * 4) = *(const f32x4*)(GA + (size_t)rc * 16 + tid * 4);
#pragma unroll
    for (int i = 0; i < 4; ++i) {
        const int vc = (wid + 8 * i) * 8;
        const u32x4 raw = *(const u32x4*)(GV + (size_t)(rc + lane) * 1024 + h * 256 + vc);
        LAS bf16_t* vp = VT + vc * 72 + lane;
        vp[0 * 72] = (bf16_t)(raw.x & 0xffffu); vp[1 * 72] = (bf16_t)(raw.x >> 16); vp[2 * 72] = (bf16_t)(raw.y & 0xffffu); vp[3 * 72] = (bf16_t)(raw.y >> 16);
        vp[4 * 72] = (bf16_t)(raw.z & 0xffffu); vp[5 * 72] = (bf16_t)(raw.z >> 16); vp[6 * 72] = (bf16_t)(raw.w & 0xffffu); vp[7 * 72] = (bf16_t)(raw.w >> 16);
    }
    float wg[16];
#pragma unroll
    for (int j = 0; j < 16; ++j) wg[j] = w_gate[j * 512 + h * 128 + c];
    const float bg = b_gate[h * 128 + c];
    unsigned short qraw[16], kraw[16];
#pragma unroll
    for (int tt = 0; tt < 16; ++tt) { const int t = seg * 16 + tt; qraw[tt] = GQ[(size_t)(rc + t) * 512 + h * 128 + c]; kraw[tt] = GK[(size_t)(rc + t) * 512 + h * 128 + c]; }
    __syncthreads();
    float bc[16]; float run = 0.f;
#pragma unroll
    for (int tt = 0; tt < 16; ++tt) {
        const int t = seg * 16 + tt; float x = bg;
#pragma unroll
        for (int j4 = 0; j4 < 4; ++j4) { const f32x4 a = *(const LAS f32x4*)(GAL + t * 16 + j4 * 4); x += a[0] * wg[j4 * 4] + a[1] * wg[j4 * 4 + 1] + a[2] * wg[j4 * 4 + 2] + a[3] * wg[j4 * 4 + 3]; }
        run += logsigmoidf_(x) * (1.f / 16.f); bc[tt] = run;
    }
    SEGTOT[seg * 128 + c] = run; if (seg == 2) BFIRST[c] = bc[0];
    __syncthreads();
    {
        const float s0 = SEGTOT[c], s1 = SEGTOT[128 + c], s2 = SEGTOT[256 + c], s3 = SEGTOT[384 + c];
        const float offs = (seg == 0) ? 0.f : (seg == 1) ? s0 : (seg == 2) ? (s0 + s1) : (s0 + s1 + s2);
        const float blast = s0 + s1 + s2 + s3, bref = s0 + s1 + BFIRST[c];
        if (seg == 0) DECAY[c] = fexp2(blast * LOG2E);
#pragma unroll
        for (int tt = 0; tt < 16; ++tt) {
            const int t = seg * 16 + tt; const float B = offs + bc[tt];
            const float qv = bf2f(qraw[tt]), kv = bf2f(kraw[tt]);
            QT[t * 136 + c] = f2bf(qv * fexp2((B - bref) * LOG2E)); KT[t * 136 + c] = f2bf(kv * fexp2((bref - B) * LOG2E));
            QD[t * 136 + c] = f2bf(qv * fexp2(B * LOG2E)); KDT[c * 72 + t] = f2bf(kv * fexp2((blast - B) * LOG2E));
        }
    }
    __syncthreads();
#pragma unroll
    for (int q = 0; q < 2; ++q) {
        const int id = wid * 2 + q, tm = id >> 2, sn = id & 3;
        f32x4 a = (f32x4){0.f, 0.f, 0.f, 0.f};
        if (sn <= tm) {
#pragma unroll
            for (int ks = 0; ks < 4; ++ks) { const bf16x8 kf = *(const LAS bf16x8*)(KT + (sn * 16 + fr) * 136 + ks * 32 + fq * 8), qf = *(const LAS bf16x8*)(QT + (tm * 16 + fr) * 136 + ks * 32 + fq * 8); a = mfma16(kf, qf, a); }
            if (sn == tm) {
#pragma unroll
                for (int e = 0; e < 4; ++e) if (fq * 4 + e > fr) a[e] = 0.f;
            }
        }
        u32x2 w; w.x = cvt_pk_bf16(a[0], a[1]); w.y = cvt_pk_bf16(a[2], a[3]);
        *(LAS u32x2*)(ATT + (tm * 16 + fr) * 72 + sn * 16 + fq * 4) = w;
    }
#pragma unroll
    for (int j = 0; j < 2; ++j) {
        const int id = tid + 512 * j, pair = id >> 6, tt = pair >> 2, i = pair & 3, ln = id & 63, fr2 = ln & 15, fq2 = ln >> 4;
        const u32x2 lo = *(const LAS u32x2*)(QD + (tt * 16 + fr2) * 136 + 32 * i + fq2 * 4), hi2 = *(const LAS u32x2*)(QD + (tt * 16 + fr2) * 136 + 32 * i + 16 + fq2 * 4);
        u32x4 w; w.x = lo.x; w.y = lo.y; w.z = hi2.x; w.w = hi2.y;
        *(u32x4*)(QDF + (size_t)id * 8) = w;
    }
    if (tid < 128) DEC[tid] = DECAY[tid];
    __syncthreads();
    {
        f32x4 o[2][4];
#pragma unroll
        for (int vt = 0; vt < 2; ++vt)
#pragma unroll
            for (int tt = 0; tt < 4; ++tt) o[vt][tt] = (f32x4){0.f, 0.f, 0.f, 0.f};
#pragma unroll
        for (int ks = 0; ks < 2; ++ks) {
            const bf16x8 vf0 = *(const LAS bf16x8*)(VT + (32 * wid + fr) * 72 + ks * 32 + fq * 8), vf1 = *(const LAS bf16x8*)(VT + (32 * wid + 16 + fr) * 72 + ks * 32 + fq * 8);
#pragma unroll
            for (int tt = 0; tt < 4; ++tt) {
                if (tt * 16 + 15 >= ks * 32) {
                    const bf16x8 af = *(const LAS bf16x8*)(ATT + (tt * 16 + fr) * 72 + ks * 32 + fq * 8);
                    o[0][tt] = mfma16(vf0, af, o[0][tt]); o[1][tt] = mfma16(vf1, af, o[1][tt]);
                }
            }
        }
#pragma unroll
        for (int tt = 0; tt < 4; ++tt) {
            u32x4 w; w.x = cvt_pk_bf16(o[0][tt][0], o[0][tt][1]); w.y = cvt_pk_bf16(o[0][tt][2], o[0][tt][3]); w.z = cvt_pk_bf16(o[1][tt][0], o[1][tt][1]); w.w = cvt_pk_bf16(o[1][tt][2], o[1][tt][3]);
            *(u32x4*)(OI + ((wid * 4 + tt) * 64 + lane) * 8) = w;
        }
    }
    {
        const bf16x8 vf00 = *(const LAS bf16x8*)(VT + (32 * wid + fr) * 72 + fq * 8), vf01 = *(const LAS bf16x8*)(VT + (32 * wid + fr) * 72 + 32 + fq * 8);
        const bf16x8 vf10 = *(const LAS bf16x8*)(VT + (32 * wid + 16 + fr) * 72 + fq * 8), vf11 = *(const LAS bf16x8*)(VT + (32 * wid + 16 + fr) * 72 + 32 + fq * 8);
#pragma unroll
        for (int mt = 0; mt < 8; ++mt) {
            const bf16x8 kf0 = *(const LAS bf16x8*)(KDT + (mt * 16 + fr) * 72 + fq * 8), kf1 = *(const LAS bf16x8*)(KDT + (mt * 16 + fr) * 72 + 32 + fq * 8);
            f32x4 u0 = (f32x4){0.f, 0.f, 0.f, 0.f}, u1 = u0;
            u0 = mfma16(kf0, vf00, u0); u0 = mfma16(kf1, vf01, u0);
            u1 = mfma16(kf0, vf10, u1); u1 = mfma16(kf1, vf11, u1);
            u32x4 w; w.x = cvt_pk_bf16(u0[0], u0[1]); w.y = cvt_pk_bf16(u0[2], u0[3]); w.z = cvt_pk_bf16(u1[0], u1[1]); w.w = cvt_pk_bf16(u1[2], u1[3]);
            *(u32x4*)(UC + ((wid * 8 + mt) * 64 + lane) * 8) = w;
        }
    }
}

__device__ __forceinline__ void gla_seq_unit(LAS unsigned char* lds, int b, int h, unsigned char* ws, const float* o_norm, bool dry) {
    int tid_ = threadIdx.x; asm volatile("" : "+v"(tid_));
    const int tid = tid_, wid = __builtin_amdgcn_readfirstlane(tid >> 6), lane = tid & 63, fr = lane & 15, fq = lane >> 4;
    LAS float* PART = (LAS float*)lds;
    LAS bf16_t* QDFL = (LAS bf16_t*)(lds + 2048);
    LAS float* DECL = (LAS float*)(lds + 2048 + 16384);
    bf16_t* GR = (bf16_t*)(ws + Z_GR);
    f32x4 S[8][2];
#pragma unroll
    for (int i = 0; i < 8; ++i) { S[i][0] = (f32x4){0.f, 0.f, 0.f, 0.f}; S[i][1] = (f32x4){0.f, 0.f, 0.f, 0.f}; }
    u32x4 ucp[8];
    { const bf16_t* UC0 = (const bf16_t*)(ws + WS_UC) + (size_t)((b * 4 + h) * 32) * 32768;
#pragma unroll
      for (int mt = 0; mt < 6; ++mt) ucp[mt] = *(const u32x4*)(UC0 + ((wid * 8 + mt) * 64 + lane) * 8); }
    for (int ci = 0; ci < 32; ++ci) {
        asm volatile("" ::: "memory");
        const int unit = (b * 4 + h) * 32 + ci, rc = b * SEQ + ci * 64;
        const bf16_t* OI = (const bf16_t*)(ws + WS_OI) + (size_t)unit * 16384;
        const bf16_t* UC = (const bf16_t*)(ws + WS_UC) + (size_t)unit * 32768;
        const bf16_t* QDF = (const bf16_t*)(ws + WS_QDF) + (size_t)unit * 8192;
        const float* DEC = (const float*)(ws + WS_DEC) + (size_t)unit * 128;
        const u32x4 qst0 = *(const u32x4*)(QDF + tid * 8), qst1 = *(const u32x4*)(QDF + (tid + 512) * 8);
        const float dst = DEC[tid & 127];
        u32x2 rr8[4][2];
#pragma unroll
        for (int tt = 0; tt < 4; ++tt)
#pragma unroll
            for (int vt = 0; vt < 2; ++vt) rr8[tt][vt] = *(const u32x2*)(GR + (size_t)(rc + tt * 16 + fr) * 1024 + h * 256 + 32 * wid + vt * 16 + fq * 4);
        ucp[6] = *(const u32x4*)(UC + ((wid * 8 + 6) * 64 + lane) * 8); ucp[7] = *(const u32x4*)(UC + ((wid * 8 + 7) * 64 + lane) * 8);
        u32x4 oip[4];
#pragma unroll
        for (int tt = 0; tt < 4; ++tt) oip[tt] = *(const u32x4*)(OI + ((wid * 4 + tt) * 64 + lane) * 8);
        __syncthreads();
        *(LAS u32x4*)(QDFL + tid * 8) = qst0; *(LAS u32x4*)(QDFL + (tid + 512) * 8) = qst1; if (tid < 128) DECL[tid] = dst;
        __syncthreads();
        f32x4 o[2][4];
#pragma unroll
        for (int tt = 0; tt < 4; ++tt) {
            o[0][tt][0] = bflo(oip[tt].x); o[0][tt][1] = bfhi(oip[tt].x); o[0][tt][2] = bflo(oip[tt].y); o[0][tt][3] = bfhi(oip[tt].y);
            o[1][tt][0] = bflo(oip[tt].z); o[1][tt][1] = bfhi(oip[tt].z); o[1][tt][2] = bflo(oip[tt].w); o[1][tt][3] = bfhi(oip[tt].w);
        }
#pragma unroll
        for (int i = 0; i < 4; ++i) {
            bf16x8 sf[2];
#pragma unroll
            for (int vt = 0; vt < 2; ++vt) sf[vt] = mk8(cvt_pk_bf16(S[2 * i][vt][0], S[2 * i][vt][1]), cvt_pk_bf16(S[2 * i][vt][2], S[2 * i][vt][3]), cvt_pk_bf16(S[2 * i + 1][vt][0], S[2 * i + 1][vt][1]), cvt_pk_bf16(S[2 * i + 1][vt][2], S[2 * i + 1][vt][3]));
#pragma unroll
            for (int tt = 0; tt < 4; ++tt) {
                const bf16x8 qf = *(const LAS bf16x8*)(QDFL + (tt * 4 + i) * 512 + lane * 8);
                o[0][tt] = mfma16(sf[0], qf, o[0][tt]); o[1][tt] = mfma16(sf[1], qf, o[1][tt]);
            }
        }
#pragma unroll
        for (int mt = 0; mt < 8; ++mt) {
            const f32x4 dec = *(const LAS f32x4*)(DECL + mt * 16 + fq * 4);
            f32x4 u0, u1; u0[0] = bflo(ucp[mt].x); u0[1] = bfhi(ucp[mt].x); u0[2] = bflo(ucp[mt].y); u0[3] = bfhi(ucp[mt].y); u1[0] = bflo(ucp[mt].z); u1[1] = bfhi(ucp[mt].z); u1[2] = bflo(ucp[mt].w); u1[3] = bfhi(ucp[mt].w);
            S[mt][0] = S[mt][0] * dec + u0; S[mt][1] = S[mt][1] * dec + u1;
        }
        asm volatile("" ::: "memory");
        { const bf16_t* UCn = UC + ((ci + 1 < 32) ? 32768 : 0);
#pragma unroll
          for (int mt = 0; mt < 6; ++mt) ucp[mt] = *(const u32x4*)(UCn + ((wid * 8 + mt) * 64 + lane) * 8); }
#pragma unroll
        for (int tt = 0; tt < 4; ++tt) {
            float p = 0.f;
#pragma unroll
            for (int vt = 0; vt < 2; ++vt)
#pragma unroll
                for (int e = 0; e < 4; ++e) p += o[vt][tt][e] * o[vt][tt][e];
            p += __shfl_xor(p, 16); p += __shfl_xor(p, 32);
            if (fq == 0) PART[wid * 64 + tt * 16 + fr] = p;
        }
        __syncthreads();
#pragma unroll
        for (int tt = 0; tt < 4; ++tt) {
            const int t = tt * 16 + fr; float tot = 0.f;
#pragma unroll
            for (int w = 0; w < 8; ++w) tot += PART[w * 64 + t];
            const float rs = frsq(tot * (1.f / 256.f) + EPS);
#pragma unroll
            for (int vt = 0; vt < 2; ++vt) {
                const int vcol = 32 * wid + vt * 16 + fq * 4;
                bf16_t* rp = GR + (size_t)(rc + t) * 1024 + h * 256 + vcol;
                const u32x2 rr = rr8[tt][vt]; const f32x4 on = *(const f32x4*)(o_norm + h * 256 + vcol);
                u32x2 w; w.x = cvt_pk_bf16(o[vt][tt][0] * rs * on[0] * siluf_(bflo(rr.x)), o[vt][tt][1] * rs * on[1] * siluf_(bfhi(rr.x)));
                w.y = cvt_pk_bf16(o[vt][tt][2] * rs * on[2] * siluf_(bflo(rr.y)), o[vt][tt][3] * rs * on[3] * siluf_(bfhi(rr.y)));
                if (!dry) *(u32x2*)rp = w;
            }
        }
    }
}
struct Args { const float* in[28]; float* out; unsigned char* ws; int ph_lo, ph_hi; };
constexpr int N_PHASES = 27;
constexpr int NPL = 13;


#define XB_TMO      128
#define XB_XCNT(j)  (256  + 64 * (j))
#define XB_XSUB(j)  (1280 + 64 * (j))
#define XB_XGEN(j)  (2304 + 64 * (j))
#define XB_TOP      3328
#define XB_TOPGEN   3392
#define XCD_BAR_WORDS 3456
#define XB_SPIN_CAP (1u << 18)
__device__ __forceinline__ unsigned xb_ld(unsigned* p)              { return __hip_atomic_load(p, __ATOMIC_RELAXED, __HIP_MEMORY_SCOPE_AGENT); }
__device__ __forceinline__ unsigned xb_add(unsigned* p, unsigned v) { return __hip_atomic_fetch_add(p, v, __ATOMIC_RELAXED, __HIP_MEMORY_SCOPE_AGENT); }
__device__ __forceinline__ unsigned xb_xcc_id() { return (unsigned)__builtin_amdgcn_s_getreg((3 << 11) | 20) & 0xFu; }
#define XB_SPIN(cond, bar) do { unsigned _sp = 0; while (cond) { __builtin_amdgcn_s_sleep(1); \
    if ((++_sp & 255u) == 0u) { if (xb_ld(&(bar)[XB_TMO])) break; if (_sp > XB_SPIN_CAP) { atomicAdd(&(bar)[XB_TMO], 1u); break; } } } } while (0)
__device__ __forceinline__ void xcd_barrier_complete(unsigned* bar, unsigned x, unsigned G, unsigned& nloc, unsigned& nx) {
    unsigned sum, cnt, mine, sp = 0u;
    for (;;) {
        sum = 0u; cnt = 0u; mine = 0u;
#pragma unroll
        for (unsigned j = 0; j < 16; ++j) { const unsigned c = xb_ld(&bar[XB_XCNT(j)]); sum += c; cnt += (c > 0u) ? 1u : 0u; mine = (j == x) ? c : mine; }
        if (sum == G) break;
        __builtin_amdgcn_s_sleep(1);
        if ((++sp & 255u) == 0u) { if (xb_ld(&bar[XB_TMO])) break; if (sp > XB_SPIN_CAP) { atomicAdd(&bar[XB_TMO], 1u); break; } }
    }
    nloc = mine > 0u ? mine : 1u; nx = cnt > 0u ? cnt : 1u;
}
__device__ __forceinline__ void xcd_barrier(unsigned* bar, volatile LAS unsigned* st, bool tid0, unsigned G) {
    asm volatile("s_waitcnt vmcnt(0)" ::: "memory");
    __syncthreads();
    if (tid0) {
        const unsigned x = xb_xcc_id();
        __builtin_amdgcn_s_waitcnt(0);
        unsigned nloc = st[0], nx = st[1];
        if (nloc == 0u) { xcd_barrier_complete(bar, x, G, nloc, nx); st[0] = nloc; st[1] = nx; }
        const unsigned old = xb_add(&bar[XB_XSUB(x)], 1u);
        const unsigned gen = old / nloc;
        if (old + 1u == (gen + 1u) * nloc) {
            __builtin_amdgcn_fence(__ATOMIC_RELEASE, "agent");
            asm volatile("s_waitcnt vmcnt(0)" ::: "memory");
            const unsigned og = xb_add(&bar[XB_TOP], 1u);
            const unsigned tg = og / nx;
            if (og + 1u == (tg + 1u) * nx) xb_add(&bar[XB_TOPGEN], 1u);
            else XB_SPIN(xb_ld(&bar[XB_TOPGEN]) == tg, bar);
            __builtin_amdgcn_fence(__ATOMIC_ACQUIRE, "agent");
            xb_add(&bar[XB_XGEN(x)], 1u);
            asm volatile("s_waitcnt vmcnt(0)" ::: "memory");
        } else {
            XB_SPIN(xb_ld(&bar[XB_XGEN(x)]) == gen, bar);
            __builtin_amdgcn_fence(__ATOMIC_ACQUIRE, "agent");
            asm volatile("s_waitcnt vmcnt(0)" ::: "memory");
        }
    }
    __syncthreads();
}

__device__ __forceinline__ int queue_pop(unsigned* ctr, LAS int* slot) {
    int tid_ = threadIdx.x; asm volatile("" : "+v"(tid_));
    __syncthreads();
    if (tid_ == 0) *slot = (int)atomicAdd(ctr, 1u);
    __syncthreads();
    return *slot;
}

__global__ void __launch_bounds__(NTHREADS, 2) fwd_kernel(Args a) {
    extern __shared__ __attribute__((aligned(16))) unsigned char lds_raw[];
    LAS unsigned char* lds = (LAS unsigned char*)lds_raw;
    typedef const __attribute__((address_space(4))) Args* KArgs;
    const int ph_lo = a.ph_lo, ph_hi = a.ph_hi;
    volatile LAS unsigned* xb_st = (volatile LAS unsigned*)(lds + MISC_OFF + 64);
    if (MK_LAUNCHES == 1) {
        if (threadIdx.x == 0) { xb_st[0] = 0u; xb_st[1] = 0u; (void)xb_add((unsigned*)(a.ws + WS_CTL + CTL_BAR) + XB_XCNT(xb_xcc_id()), 1u); }
        __syncthreads();
    }
#ifndef PROBE_RPT
#define PROBE_RPT (-1)
#endif
    constexpr int NVP = (PROBE_RPT >= 0) ? 2 : 0;
    for (int vp = ph_lo; vp < ph_hi + NVP; ++vp) {
        int ph = vp; bool dry = false;
        int tid = threadIdx.x; asm volatile("" : "+v"(tid));
        int G = gridDim.x, bx = blockIdx.x; asm volatile("" : "+s"(G), "+s"(bx));
        if (PROBE_RPT >= 0) {
            constexpr int P1 = PROBE_RPT, P2 = NPL + PROBE_RPT;
            if (vp <= P1) { ph = vp; dry = (vp == P1); } else if (vp <= P2 + 1) { ph = vp - 1; dry = (vp == P2 + 1); } else ph = vp - 2;
        }
        KArgs ap = (KArgs)__builtin_amdgcn_kernarg_segment_ptr(); asm volatile("" : "+s"(ap));
#define AIN(i) (ap->in[i])
        unsigned char* ws = ap->ws; float* out = ap->out;
        u64* ssq_all = (u64*)(ws + WS_CTL + CTL_SSQ);
        u64* ssqm = (u64*)(ws + WS_SSQM);
        unsigned* qctr = (unsigned*)(ws + WS_CTL);
        bf16_t* HB = (bf16_t*)(ws + WS_HB); bf16_t* MB = (bf16_t*)(ws + WS_MB); bf16_t* MEMB = (bf16_t*)(ws + WS_MEMB); bf16_t* KVB = (bf16_t*)(ws + WS_KV);
        bf16_t* ACT = (bf16_t*)(ws + WS_ACT); bf16_t* XQB = (bf16_t*)(ws + WS_XQB); bf16_t* XOB = (bf16_t*)(ws + WS_XOB);
        float* M32 = (float*)(ws + WS_M32);
        if (ph == 2 * NPL) {
            const u64* ssq = ssq_all + (size_t)8 * T; const float* fg = AIN(27);
            const int lane = tid & 63, gw = bx * 8 + (tid >> 6), nw = G * 8;
            for (int r = gw; r < T; r += nw) {
                const float rs = rstd_of(ssq[r]); float* hr = out + (size_t)r * D;
#pragma unroll
                for (int i = 0; i < 8; ++i) { const int cidx = (i * 64 + lane) * 4; const f32x4 v = *(const f32x4*)(hr + cidx); const f32x4 gg = *(const f32x4*)(fg + cidx); *(f32x4*)(hr + cidx) = v * rs * gg; }
            }
        } else {
            const int l = ph / NPL, k = ph - l * NPL;
            switch (k) {
#ifndef PH_MASK
#define PH_MASK 0xfff
#endif
            case 0: { if (!(PH_MASK & (1 << 0))) break;
                int base = 0;
                prep_job<1>(lds, AIN(3) + (size_t)l * D * 2 * DFF, D, 2 * DFF, (bf16_t*)(ws + W_FFN1_IN), 2 * DFF, AIN(2) + l * D, 1.f, base, G, bx);
                prep_job<0>(lds, AIN(4) + (size_t)l * DFF * D, DFF, D, (bf16_t*)(ws + W_FFN1_OUT), D, nullptr, 0.5f, base, G, bx);
                prep_job<2>(lds, AIN(6) + (size_t)l * D * 14360, D, 14360, (bf16_t*)(ws + W_IN), NINP, AIN(5) + l * D, 1.f, base, G, bx);
                prep_job<0>(lds, AIN(15) + (size_t)l * 1024 * D, 1024, D, (bf16_t*)(ws + W_BA), D, nullptr, 1.f, base, G, bx);
                prep_job<0>(lds, AIN(16) + (size_t)l * 1024 * D, 1024, D, (bf16_t*)(ws + W_BB), D, nullptr, 1.f, base, G, bx);
                prep_job<0>(lds, AIN(17) + (size_t)l * 1024 * D, 1024, D, (bf16_t*)(ws + W_BC), D, nullptr, 1.f, base, G, bx);
                prep_job<0>(lds, AIN(18) + (size_t)l * D * D, D, D, (bf16_t*)(ws + W_OUT), D, nullptr, 1.f, base, G, bx);
                prep_job<0>(lds, AIN(21) + (size_t)l * D * 512, D, 512, (bf16_t*)(ws + W_XQ), 512, AIN(19) + l * D, 0.08838834764831845f * LOG2E, base, G, bx);
                prep_job<0>(lds, AIN(22) + (size_t)l * D * 1024, D, 1024, (bf16_t*)(ws + W_XKV), 1024, AIN(20) + l * D, 1.f, base, G, bx);
                prep_job<0>(lds, AIN(23) + (size_t)l * 512 * D, 512, D, (bf16_t*)(ws + W_XO), D, nullptr, 1.f, base, G, bx);
                prep_job<1>(lds, AIN(25) + (size_t)l * D * 2 * DFF, D, 2 * DFF, (bf16_t*)(ws + W_FFN2_IN), 2 * DFF, AIN(24) + l * D, 1.f, base, G, bx);
                prep_job<0>(lds, AIN(26) + (size_t)l * DFF * D, DFF, D, (bf16_t*)(ws + W_FFN2_OUT), D, nullptr, 0.5f, base, G, bx);
                if (l == 0) {
                    const int gw = bx * 8 + (tid >> 6), nw = G * 8;
                    rows_to_bf16(AIN(0), HB, ssq_all, T, gw, nw);
                    rows_to_bf16(AIN(1), MEMB, ssqm, MEMT, gw, nw);
                }
            } break;
            case 1: case 11: { if (!(PH_MASK & (1 << 1))) break;
                pg8::Gemm g{HB, (const bf16_t*)(ws + (k == 1 ? W_FFN1_IN : W_FFN2_IN)), T, 2 * DFF, D};
                pg8::StaticOrder S; S.init(T, 2 * DFF, G, bx);
                pg8::EpiSwiGLU E{ACT, ssq_all + (size_t)(4 * l + (k == 1 ? 0 : 3)) * T};
                pg8::gemm_phase(lds, g, S, E);
            } break;
            case 2: case 12: { if (!(PH_MASK & (1 << 2))) break;
                pg8::Gemm g{ACT, (const bf16_t*)(ws + (k == 2 ? W_FFN1_OUT : W_FFN2_OUT)), T, D, DFF};
                pg8::StaticOrder S; S.init(T, D, G, bx);
                pg8::EpiResid E{(l == 0 && k == 2) ? AIN(0) : out, out, HB, ssq_all + (size_t)(4 * l + (k == 2 ? 1 : 4)) * T, (int)dry};
                pg8::gemm_phase(lds, g, S, E);
            } break;
            case 3: { if (!(PH_MASK & (1 << 3))) break;
                pg8::Gemm g{HB, (const bf16_t*)(ws + W_IN), T, NINP - 256, D};
                pg8::StaticOrder S; S.init(T, NINP - 256, G, bx);
                pg8::EpiWin E{ws, ssq_all + (size_t)(4 * l + 1) * T};
                pg8::gemm_phase(lds, g, S, E);
                for (int rb = bx; rb < T / 64; rb += G)
                    narrow_cols_unit(lds, rb, HB, (const bf16_t*)(ws + W_IN) + (size_t)(NINP - 256) * D, ssq_all + (size_t)(4 * l + 1) * T, AIN(11) + l * 8, (float*)(ws + WS_LOGF), (float*)(ws + WS_GA));
            } break;
            case 4: { if (!(PH_MASK & (1 << 4))) break;
                LAS int* slot = (LAS int*)(lds + MISC_OFF);
                for (;;) {
                    const int u = queue_pop(qctr + l + (dry ? 4 : 0), slot);
                    if (u >= 1024 + 512) break;
                    if (u < 1024) {
                        gla_pre_unit(lds, u >> 7, (u >> 5) & 3, u & 31, ws, AIN(12) + (size_t)l * 16 * 512, AIN(13) + l * 512);
                    } else {
                        const int s = u - 1024, g = s & 3, n = (s >> 2) & 15, b = s >> 6;
                        sgu_unit(lds, b, n, g, (const bf16_t*)(ws + Z_V), (bf16_t*)(ws + Z_U), AIN(7) + l * 1024, AIN(8) + l * 1024, AIN(9) + (size_t)l * 4 * 128 * 128, AIN(10) + l * 512, dry);
                    }
                }
            } break;
            case 5: { if (!(PH_MASK & (1 << 5))) break;
                if (bx < 32) { gla_seq_unit(lds, bx >> 2, bx & 3, ws, AIN(14) + l * 1024, dry); }
                else {
                    if (!dry) {
                        pg8::StaticOrder S; S.init(T, D, G - 32, bx - 32);
                        pg8::Gemm g{(const bf16_t*)(ws + Z_U), (const bf16_t*)(ws + W_BA), T, D, 1024}; pg8::EpiBranch E{(const bf16_t*)(ws + Z_GATES), M32, MB, (bf16_t*)(ws + WS_MA), 0}; pg8::gemm_phase(lds, g, S, E);
                    }
                    __syncthreads();
                    LAS int* slot = (LAS int*)(lds + MISC_OFF);
                    for (;;) {
                        const int q = queue_pop(qctr + 2 + l + (dry ? 4 : 0), slot);
                        if (q >= 512) break;
                        const int qb = 7 - (q >> 6), bh = q & 63, b = bh >> 3, h = bh & 7;
                        const size_t rb = (size_t)b * SEQ;
                        bf16_t* FQ = (bf16_t*)(ws + Z_FQ); const bf16_t* FK = (const bf16_t*)(ws + Z_FK); const bf16_t* FV = (const bf16_t*)(ws + Z_FV);
                        attn_unit<true>(lds, FQ + (rb + qb * 256) * 1024 + h * 128, 1024, FK + rb * 1024 + h * 128, FV + rb * 1024 + h * 128, 1024,
                                        FQ + (rb + qb * 256) * 1024 + h * 128, 1024, (qb + 1) * 4, qb * 256, (const float*)(ws + WS_LOGF) + rb * 8 + h, dry);
                    }
                }
            } break;
            case 6: { if (!(PH_MASK & (1 << 6))) break;
                pg8::StaticOrder S; S.init(T, D, G, bx);
                const bf16_t* gates = (const bf16_t*)(ws + Z_GATES);
                { pg8::Gemm g{(const bf16_t*)(ws + Z_FQ), (const bf16_t*)(ws + W_BB), T, D, 1024}; pg8::EpiBranch E{gates, M32, MB, (bf16_t*)(ws + WS_MA), 1}; pg8::gemm_phase(lds, g, S, E); }
                { pg8::Gemm g{(const bf16_t*)(ws + Z_GR), (const bf16_t*)(ws + W_BC), T, D, 1024}; pg8::EpiBranch E{gates, M32, MB, (bf16_t*)(ws + WS_MA), 2}; pg8::gemm_phase(lds, g, S, E); }
            } break;
            case 7: { if (!(PH_MASK & (1 << 7))) break;
                pg8::Gemm g{MB, (const bf16_t*)(ws + W_OUT), T, D, D};
                pg8::StaticOrder S; S.init(T, D, G, bx);
                pg8::EpiResid E{out, out, HB, ssq_all + (size_t)(4 * l + 2) * T, (int)dry};
                pg8::gemm_phase(lds, g, S, E);
            } break;
            case 8: { if (!(PH_MASK & (1 << 8))) break;
                { pg8::Gemm g{HB, (const bf16_t*)(ws + W_XQ), T, 512, D}; pg8::StaticOrder S; S.init(T, 512, G, bx);
                  pg8::EpiRowScale E{XQB, 512, ssq_all + (size_t)(4 * l + 2) * T}; pg8::gemm_phase(lds, g, S, E); }
                { pg8::Gemm g{MEMB, (const bf16_t*)(ws + W_XKV), MEMT, 1024, D}; pg8::StaticOrder S; S.init(MEMT, 1024, G, (bx + G - 128) % G);
                  pg8::EpiRowScale E{KVB, 1024, ssqm}; pg8::gemm_phase(lds, g, S, E); }
            } break;
            case 9: { if (!(PH_MASK & (1 << 9))) break;
                for (int u = bx; u < 256; u += G) {
                    const int qb = u & 7, h = (u >> 3) & 3, b = u >> 5;
                    const size_t rq = (size_t)b * SEQ + qb * 256, rk = (size_t)b * 256;
                    attn_unit<false>(lds, XQB + rq * 512 + h * 128, 512, KVB + rk * 1024 + h * 128, KVB + rk * 1024 + 512 + h * 128, 1024, XOB + rq * 512 + h * 128, 512, 4, 0, nullptr, false);
                }
            } break;
            case 10: { if (!(PH_MASK & (1 << 10))) break;
                pg8::Gemm g{XOB, (const bf16_t*)(ws + W_XO), T, D, 512};
                pg8::StaticOrder S; S.init(T, D, G, bx);
                pg8::EpiResid E{out, out, HB, ssq_all + (size_t)(4 * l + 3) * T, (int)dry};
                pg8::gemm_phase(lds, g, S, E);
            } break;
            default: break;
            }
        }
        if (vp + 1 < ph_hi + NVP) {
            if (vp == ph_lo) cg::this_grid().sync();
            else xcd_barrier((unsigned*)(ws + WS_CTL + CTL_BAR), xb_st, tid == 0, (unsigned)G);
        }
    }
}

extern "C" void kernel_launch(void* const* d_in, const int* in_sizes, int n_in, void* d_out, int out_size, void* d_ws, size_t ws_size, hipStream_t stream) {
    static int grid = 0;
    if (grid == 0) {
        if (n_in != 28 || out_size != T * D || ws_size < WS_END) { fprintf(stderr, "kernel_launch: unexpected shapes (n_in %d, out %d, ws %zu < %zu)\n", n_in, out_size, ws_size, (size_t)WS_END); grid = -1; return; }
        int dev = 0, cus = 0, per_cu = 0;
        hipGetDevice(&dev); hipDeviceGetAttribute(&cus, hipDeviceAttributeMultiprocessorCount, dev);
        if (hipFuncSetAttribute((const void*)fwd_kernel, hipFuncAttributeMaxDynamicSharedMemorySize, LDS_BYTES) != hipSuccess) { fprintf(stderr, "kernel_launch: hipFuncSetAttribute failed\n"); grid = -1; return; }
        if (hipOccupancyMaxActiveBlocksPerMultiprocessor(&per_cu, (const void*)fwd_kernel, NTHREADS, LDS_BYTES) != hipSuccess || per_cu < 1) { fprintf(stderr, "kernel_launch: occupancy query says %d\n", per_cu); per_cu = 1; }
        (void)hipGetLastError();
        grid = cus * 1;
    }
    if (grid < 0) return;
    (void)hipMemsetAsync((char*)d_ws + WS_CTL, 0, CTL_BYTES, stream);
    Args a{};
    for (int i = 0; i < 28; ++i) a.in[i] = (const float*)d_in[i];
    a.out = (float*)d_out; a.ws = (unsigned char*)d_ws;
#if MK_LAUNCHES == 1
    a.ph_lo = 0; a.ph_hi = N_PHASES;
    void* args[] = {&a};
    hipError_t e = hipLaunchCooperativeKernel((const void*)fwd_kernel, dim3(grid), dim3(NTHREADS), args, LDS_BYTES, stream);
    if (e != hipSuccess) fprintf(stderr, "cooperative launch failed: %s (grid %d)\n", hipGetErrorString(e), grid);
#else
    for (int p = 0; p < N_PHASES; ++p) {
        a.ph_lo = p; a.ph_hi = p + 1;
        hipLaunchKernelGGL(fwd_kernel, dim3(grid), dim3(NTHREADS), LDS_BYTES, stream, a);
    }
#endif
}
```

```cpp
#include <hip/hip_runtime.h>
#include <hip/hip_cooperative_groups.h>
#include <cstdio>
#include <cstdint>
namespace cg = cooperative_groups;

#ifndef MK_LAUNCHES
#define MK_LAUNCHES 1
#endif

#define LAS __attribute__((address_space(3)))
typedef unsigned short bf16_t;
typedef short bf16x8 __attribute__((ext_vector_type(8)));
typedef float f32x4 __attribute__((ext_vector_type(4)));
typedef unsigned u32x4 __attribute__((ext_vector_type(4)));
typedef unsigned u32x2 __attribute__((ext_vector_type(2)));

constexpr int T = 16384, D = 2048, DFF = 5632, SEQ = 2048, NB = 8, MEMT = 2048  ;
constexpr int NINP = 14592;
constexpr float EPS = 1e-6f;
constexpr float LOG2E = 1.4426950408889634f, LN2 = 0.6931471805599453f;
constexpr int NTHREADS = 512;
constexpr int LDS_BYTES = 133120;
constexpr int MISC_OFF = 131072;

constexpr size_t SZ_FFN_IN = (size_t)2 * DFF * D * 2, SZ_FFN_OUT = (size_t)D * DFF * 2, SZ_WIN = (size_t)NINP * D * 2, SZ_BR = (size_t)D * 1024 * 2, SZ_WOUT = (size_t)D * D * 2;
constexpr size_t SZ_XQ = (size_t)512 * D * 2, SZ_XKV = (size_t)1024 * D * 2, SZ_XO = (size_t)D * 512 * 2;
constexpr size_t W_FFN1_IN = 0, W_FFN1_OUT = W_FFN1_IN + SZ_FFN_IN, W_IN = W_FFN1_OUT + SZ_FFN_OUT, W_BA = W_IN + SZ_WIN, W_BB = W_BA + SZ_BR, W_BC = W_BB + SZ_BR,
                 W_OUT = W_BC + SZ_BR, W_XQ = W_OUT + SZ_WOUT, W_XKV = W_XQ + SZ_XQ, W_XO = W_XKV + SZ_XKV, W_FFN2_IN = W_XO + SZ_XO, W_FFN2_OUT = W_FFN2_IN + SZ_FFN_IN,
                 W_END = W_FFN2_OUT + SZ_FFN_OUT;
constexpr size_t WS_CTL = W_END;
constexpr size_t CTL_BAR = 4096;
constexpr size_t CTL_SSQ = 4096 + 16384;
constexpr size_t CTL_BYTES = CTL_SSQ + (size_t)9 * T * 8;
constexpr size_t WS_SSQM = WS_CTL + CTL_BYTES;
constexpr size_t WS_HB = WS_SSQM + 16384;
constexpr size_t WS_MB = WS_HB + (size_t)T * D * 2;
constexpr size_t WS_MEMB = WS_MB + (size_t)T * D * 2;
constexpr size_t WS_KV = WS_MEMB + (size_t)MEMT * D * 2;
constexpr size_t WS_LOGF = WS_KV + (size_t)MEMT * 1024 * 2;
constexpr size_t WS_GA = WS_LOGF + (size_t)T * 8 * 4;
constexpr size_t WS_Z = WS_GA + (size_t)T * 16 * 4;
constexpr size_t Z_U = WS_Z, Z_FQ = Z_U + (size_t)T * 1024 * 2, Z_GR = Z_FQ + (size_t)T * 1024 * 2, Z_GATES = Z_GR + (size_t)T * 1024 * 2,
                 Z_V = Z_GATES + (size_t)T * 6144 * 2, Z_FK = Z_V + (size_t)T * 1024 * 2, Z_FV = Z_FK + (size_t)T * 1024 * 2, Z_GQ = Z_FV + (size_t)T * 1024 * 2,
                 Z_GK = Z_GQ + (size_t)T * 512 * 2, Z_GV = Z_GK + (size_t)T * 512 * 2, Z_END = Z_GV + (size_t)T * 1024 * 2;
constexpr size_t WS_MA = Z_GQ;
constexpr size_t WS_ACT = WS_Z;
constexpr size_t WS_XQB = WS_Z, WS_XOB = WS_Z + (size_t)T * 512 * 2;
constexpr size_t WS_OI = WS_MB;
constexpr size_t WS_UC = Z_END;
constexpr size_t WS_M32 = WS_UC;
constexpr size_t WS_H16 = WS_UC + (size_t)T * D * 2;
constexpr size_t WS_QDF = WS_UC + (size_t)1024 * 32768 * 4;
constexpr size_t WS_DEC = WS_QDF + (size_t)1024 * 8192 * 2;
constexpr size_t WS_END = WS_DEC + (size_t)1024 * 128 * 4;
static_assert(WS_MA + (size_t)T * D * 2 <= Z_END && WS_ACT + (size_t)T * DFF * 2 <= Z_END, "aliases fit");
static_assert(WS_CTL % 256 == 0 && WS_HB % 256 == 0 && WS_Z % 256 == 0, "alignment");

typedef float f32x2_t __attribute__((ext_vector_type(2)));
typedef __bf16 bf16x2_t __attribute__((ext_vector_type(2)));
__device__ __forceinline__ unsigned cvt_pk_bf16(float lo, float hi) { const f32x2_t v = {lo, hi}; const bf16x2_t b = __builtin_convertvector(v, bf16x2_t); return __builtin_bit_cast(unsigned, b); }
__device__ __forceinline__ float bflo(unsigned u) { return __builtin_bit_cast(float, u << 16); }
__device__ __forceinline__ float bfhi(unsigned u) { return __builtin_bit_cast(float, u & 0xffff0000u); }
__device__ __forceinline__ float bf2f(bf16_t b) { return __builtin_bit_cast(float, ((unsigned)b) << 16); }
__device__ __forceinline__ bf16_t f2bf(float f) { return (bf16_t)(cvt_pk_bf16(f, 0.f) & 0xffffu); }
__device__ __forceinline__ float fexp2(float x) { return __builtin_amdgcn_exp2f(x); }
__device__ __forceinline__ float flog2(float x) { return __builtin_amdgcn_logf(x); }
__device__ __forceinline__ float frcp(float x) { return __builtin_amdgcn_rcpf(x); }
__device__ __forceinline__ float frsq(float x) { return __builtin_amdgcn_rsqf(x); }
__device__ __forceinline__ float sigmoidf_(float x) { return frcp(1.f + fexp2(-x * LOG2E)); }
__device__ __forceinline__ float siluf_(float x) { return x * sigmoidf_(x); }
__device__ __forceinline__ float gelu_tanh(float x) { const float u = x + 0.044715f * x * x * x; return x * frcp(1.f + fexp2(-2.3022082f * u)); }
__device__ __forceinline__ float logsigmoidf_(float x) { return fminf(x, 0.f) - LN2 * flog2(1.f + fexp2(-fabsf(x) * LOG2E)); }
typedef float f32x2 __attribute__((ext_vector_type(2)));
__device__ __forceinline__ f32x2 exp2_2(f32x2 t) { f32x2 e; e.x = fexp2(t.x); e.y = fexp2(t.y); return e; }
__device__ __forceinline__ f32x2 rcp_2(f32x2 d) { f32x2 r; r.x = frcp(d.x); r.y = frcp(d.y); return r; }
__device__ __forceinline__ f32x2 swiglu2(f32x2 g, f32x2 u, float na, float rs2) { const f32x2 r = rcp_2(exp2_2(g * na) + 1.0f); return (g * u) * (r * rs2); }
__device__ __forceinline__ f32x2 sigmoid2(f32x2 x, float na) { return rcp_2(exp2_2(x * na) + 1.0f); }
__device__ __forceinline__ f32x2 gelu2(f32x2 x, float rs) { const f32x2 v = x * rs; const f32x2 w = v * (v * v * 0.044715f + 1.0f); return v * rcp_2(exp2_2(w * -2.3022082f) + 1.0f); }
typedef _Float16 h16x2_t __attribute__((ext_vector_type(2)));
__device__ __forceinline__ unsigned cvt_pk_f16(float lo, float hi) { const f32x2 v = {lo, hi}; const h16x2_t h = __builtin_convertvector(v, h16x2_t); return __builtin_bit_cast(unsigned, h); }
__device__ __forceinline__ f32x2 unpk_f16(unsigned u) { const h16x2_t h = __builtin_bit_cast(h16x2_t, u); return __builtin_convertvector(h, f32x2); }
typedef unsigned long long u64;
__device__ __forceinline__ float rstd_of(u64 ssq) { return frsq((float)ssq * (1.0f / (2048.0f * 16777216.0f)) + EPS); }
__device__ __forceinline__ u64 ssq_fix(float s) { return (u64)__float2ull_rn(s * 16777216.0f); }

namespace pg8 {
constexpr int BM = 256, BK = 64, HALF = 128, HTB = HALF * BK * 2, STAGE_BYTES = 8 * HTB, NXCD = 8, WGM = 8;
__host__ __device__ __forceinline__ int lds_byte(int r, int c) { const int st = (r >> 4) * 2 + (c >> 5), rr = r & 15, cc = c & 31, ob = rr * 64 + cc * 2; return st * 1024 + (ob ^ (((ob >> 9) & 1) << 5)); }
__host__ __device__ __forceinline__ void stage_rc(int b, int& R, int& C) { const int st = b / 1024, sb = b % 1024, swz = sb ^ (((sb >> 9) & 1) << 5); R = (st >> 1) * 16 + swz / 64; C = (st & 1) * 32 + (swz % 64) / 2; }
__host__ __device__ __forceinline__ int perm32(int rho) { const int n = rho >> 4, i = rho & 15; return 8 * (i >> 2) + 4 * n + (i & 3); }

struct Unit { int pm, pn; };
struct Gemm { const bf16_t* A; const bf16_t* Bt; int M, N, K; };

struct StaticOrder {
    int nM, nN, nwg, G, c;
    __device__ void init(int M, int N, int G_, int c_) { nM = M / BM; nN = N / BM; nwg = nM * nN; G = G_; c = c_; }
    __device__ bool next(int i, Unit& u) const {
        const long L = (long)i * G + c; if (L >= nwg) return false;
        int wgid = (int)L; { const int q = nwg / NXCD, r = nwg % NXCD, xcd = wgid % NXCD, off = wgid / NXCD; wgid = (xcd < r ? xcd * (q + 1) : r * (q + 1) + (xcd - r) * q) + off; }
        const int nig = WGM * nN, gid = wgid / nig, fm = gid * WGM, gsz = (nM - fm) < WGM ? (nM - fm) : WGM;
        u.pm = fm + ((wgid % nig) % gsz); u.pn = (wgid % nig) / gsz; return true;
    }
};

template <class Epi, class Sched, bool ALIGN_EPI = true, bool SP2 = true>
__device__ __forceinline__ void gemm_phase(LAS unsigned char* lds, const Gemm g, const Sched& S, const Epi& E) {
    int tid_ = threadIdx.x; asm volatile("" : "+v"(tid_));
    const int tid = tid_, wid = __builtin_amdgcn_readfirstlane(tid >> 6), lane = tid & 63, wr = wid >> 2, wc = wid & 3, fr = lane & 15, fq = lane >> 4;
    const int K = g.K, nt = K / BK;
    unsigned voffA[2], voffB[2];
#pragma unroll
    for (int i = 0; i < 2; ++i) { int R, C; stage_rc(tid * 16 + i * 8192, R, C); const int Rb = (R & ~31) + perm32(R & 31);
        voffA[i] = (unsigned)(R * K + C) * 2u; voffB[i] = (unsigned)(Rb * K + C) * 2u; }
    const size_t kstep = (size_t)(BK * 2);
    const size_t hstep = (size_t)HALF * K * 2;
    const size_t tstep = 2 * hstep;
    const unsigned ldsw = (unsigned)wid * 1024u;
    const int aoff = lds_byte(wr * 64 + fr, fq * 8), boff = lds_byte(wc * 32 + fr, fq * 8);
#define PG8_SA(b, h) (((b) * 2 + (h)) * HTB)
#define PG8_SB(b, h) ((4 + (b) * 2 + (h)) * HTB)
#define PG8_STAGE(bufoff, gbase, voff) do { _Pragma("unroll") for (int _i = 0; _i < 2; ++_i) \
        __builtin_amdgcn_global_load_lds((const unsigned*)((const char*)(gbase) + (voff)[_i]), (LAS unsigned*)(lds + (bufoff) + ldsw + _i * 8192), 16, 0, 0); } while (0)
#define PG8_LDA(dst, b, h) do { _Pragma("unroll") for (int m = 0; m < 4; ++m) _Pragma("unroll") for (int k = 0; k < 2; ++k) dst[m][k] = *(const LAS bf16x8*)(lds + PG8_SA(b, h) + aoff + m * 2048 + k * 1024); } while (0)
#define PG8_LDB(dst, b, h) do { _Pragma("unroll") for (int n = 0; n < 2; ++n) _Pragma("unroll") for (int k = 0; k < 2; ++k) dst[n][k] = *(const LAS bf16x8*)(lds + PG8_SB(b, h) + boff + n * 2048 + k * 1024); } while (0)
#define PG8_MMA(ai, bj, At, Bt) do { __builtin_amdgcn_s_setprio(1); _Pragma("unroll") for (int m = 0; m < 4; ++m) _Pragma("unroll") for (int n = 0; n < 2; ++n) _Pragma("unroll") for (int k = 0; k < 2; ++k) \
        acc[ai][bj][m][n] = __builtin_amdgcn_mfma_f32_16x16x32_bf16(Bt[n][k], At[m][k], acc[ai][bj][m][n], 0, 0, 0); __builtin_amdgcn_s_setprio(0); } while (0)
#define PG8_WAIT_V(n) asm volatile("s_waitcnt vmcnt(" #n ")" ::: "memory")
#define PG8_WAIT_L(n) asm volatile("s_waitcnt lgkmcnt(" #n ")" ::: "memory")
#define PG8_BAR __builtin_amdgcn_s_barrier()
#define PG8_SCHED __builtin_amdgcn_sched_barrier(0)
    Unit cur, nxt; int ui = 0;
    if (!S.next(0, cur)) return;
    f32x4 acc[2][2][4][2];
#pragma unroll
    for (int a = 0; a < 2; ++a)
#pragma unroll
        for (int b = 0; b < 2; ++b)
#pragma unroll
            for (int m = 0; m < 4; ++m)
#pragma unroll
                for (int n = 0; n < 2; ++n) acc[a][b][m][n] = (f32x4){0.f, 0.f, 0.f, 0.f};
    bf16x8 At[4][2], B0[2][2], B1[2][2];
    const char* cA = (const char*)g.A + (size_t)cur.pm * tstep; const char* cB = (const char*)g.Bt + (size_t)cur.pn * tstep;
    if constexpr (SP2) {
        PG8_STAGE(PG8_SB(0, 0), cB, voffB); PG8_STAGE(PG8_SB(0, 1), cB + hstep, voffB); PG8_STAGE(PG8_SA(0, 0), cA, voffA); PG8_STAGE(PG8_SA(0, 1), cA + hstep, voffA);
        if (wr == 1) PG8_BAR;
        PG8_WAIT_V(2); PG8_BAR;
        PG8_STAGE(PG8_SB(1, 0), cB + kstep, voffB); PG8_STAGE(PG8_SA(1, 0), cA + kstep, voffA); PG8_STAGE(PG8_SB(1, 1), cB + hstep + kstep, voffB);
        PG8_WAIT_V(6); PG8_BAR;
    } else {
        PG8_STAGE(PG8_SB(0, 0), cB, voffB); PG8_STAGE(PG8_SA(0, 0), cA, voffA); PG8_STAGE(PG8_SB(0, 1), cB + hstep, voffB); PG8_STAGE(PG8_SA(0, 1), cA + hstep, voffA);
        if (wr == 1) PG8_BAR;
        PG8_WAIT_V(4); PG8_BAR;
        PG8_STAGE(PG8_SB(1, 0), cB + kstep, voffB); PG8_STAGE(PG8_SA(1, 0), cA + kstep, voffA); PG8_STAGE(PG8_SB(1, 1), cB + hstep + kstep, voffB);
        PG8_WAIT_V(6); PG8_BAR;
    }
    for (;;) {
        const bool has_next = S.next(ui + 1, nxt);
        const char* nA = has_next ? (const char*)g.A + (size_t)nxt.pm * tstep : cA; const char* nB = has_next ? (const char*)g.Bt + (size_t)nxt.pn * tstep : cB;
        for (int t = 0; t < nt; t += 2) {
            const bool last = (t == nt - 2);
            const char* a1 = cA + (size_t)(t + 1) * kstep;
            const char* a2 = last ? nA : cA + (size_t)(t + 2) * kstep; const char* b2 = last ? nB : cB + (size_t)(t + 2) * kstep;
            const char* a3 = a2 + kstep; const char* b3 = b2 + kstep;
            if constexpr (SP2) {
            PG8_LDB(B0, 0, 0); PG8_LDB(B1, 0, 1); PG8_SCHED; PG8_LDA(At, 0, 0); PG8_STAGE(PG8_SA(1, 1), a1 + hstep, voffA);
            PG8_WAIT_V(8); PG8_WAIT_L(0); PG8_BAR; PG8_MMA(0, 0, At, B0); PG8_MMA(0, 1, At, B1); PG8_BAR; PG8_SCHED;
            PG8_LDA(At, 0, 1); PG8_STAGE(PG8_SB(0, 0), b2, voffB); PG8_STAGE(PG8_SB(0, 1), b2 + hstep, voffB); PG8_STAGE(PG8_SA(0, 0), a2, voffA);
            PG8_WAIT_V(8); PG8_WAIT_L(0); PG8_BAR; PG8_MMA(1, 0, At, B0); PG8_MMA(1, 1, At, B1); PG8_BAR; PG8_SCHED;
            PG8_LDB(B0, 1, 0); PG8_LDB(B1, 1, 1); PG8_SCHED; PG8_LDA(At, 1, 0); PG8_STAGE(PG8_SA(0, 1), a2 + hstep, voffA);
            PG8_WAIT_V(8); PG8_WAIT_L(0); PG8_BAR; PG8_MMA(0, 0, At, B0); PG8_MMA(0, 1, At, B1); PG8_BAR; PG8_SCHED;
            PG8_LDA(At, 1, 1); PG8_STAGE(PG8_SB(1, 0), b3, voffB); PG8_STAGE(PG8_SB(1, 1), b3 + hstep, voffB); PG8_STAGE(PG8_SA(1, 0), a3, voffA);
            PG8_WAIT_V(8); PG8_WAIT_L(0); PG8_BAR; PG8_MMA(1, 0, At, B0); PG8_MMA(1, 1, At, B1); PG8_BAR; PG8_SCHED;
            } else {
            PG8_LDB(B0, 0, 0); PG8_SCHED; PG8_LDA(At, 0, 0); PG8_STAGE(PG8_SA(1, 1), a1 + hstep, voffA);
            PG8_WAIT_L(8); PG8_BAR; PG8_WAIT_L(0); PG8_MMA(0, 0, At, B0); PG8_BAR; PG8_SCHED;
            PG8_LDB(B1, 0, 1); PG8_STAGE(PG8_SB(0, 0), b2, voffB);
            PG8_BAR; PG8_WAIT_L(0); PG8_MMA(0, 1, At, B1); PG8_BAR;
            PG8_LDA(At, 0, 1); PG8_STAGE(PG8_SA(0, 0), a2, voffA);
            PG8_BAR; PG8_WAIT_L(0); PG8_MMA(1, 0, At, B0); PG8_BAR; PG8_SCHED;
            PG8_STAGE(PG8_SB(0, 1), b2 + hstep, voffB);
            PG8_WAIT_V(6); PG8_BAR; PG8_MMA(1, 1, At, B1); PG8_BAR;
            PG8_LDB(B0, 1, 0); PG8_SCHED; PG8_LDA(At, 1, 0); PG8_STAGE(PG8_SA(0, 1), a2 + hstep, voffA);
            PG8_WAIT_L(8); PG8_BAR; PG8_WAIT_L(0); PG8_MMA(0, 0, At, B0); PG8_BAR; PG8_SCHED;
            PG8_LDB(B1, 1, 1); PG8_STAGE(PG8_SB(1, 0), b3, voffB);
            PG8_BAR; PG8_WAIT_L(0); PG8_MMA(0, 1, At, B1); PG8_BAR;
            PG8_LDA(At, 1, 1); PG8_STAGE(PG8_SA(1, 0), a3, voffA);
            PG8_BAR; PG8_WAIT_L(0); PG8_MMA(1, 0, At, B0); PG8_BAR; PG8_SCHED;
            PG8_STAGE(PG8_SB(1, 1), b3 + hstep, voffB);
            PG8_WAIT_V(6); PG8_BAR; PG8_MMA(1, 1, At, B1); PG8_BAR;
            }
        }
        if constexpr (ALIGN_EPI) { if (wr == 0) PG8_BAR; }
        E(acc, cur, wr, wc, fr, fq);
        if (!has_next) break;
#pragma unroll
        for (int a = 0; a < 2; ++a)
#pragma unroll
            for (int b = 0; b < 2; ++b)
#pragma unroll
                for (int m = 0; m < 4; ++m)
#pragma unroll
                    for (int n = 0; n < 2; ++n) acc[a][b][m][n] = (f32x4){0.f, 0.f, 0.f, 0.f};
        cur = nxt; cA = nA; cB = nB; ++ui;
        if constexpr (ALIGN_EPI) { if (wr == 1) PG8_BAR; }
    }
    PG8_WAIT_V(0);
    if constexpr (!ALIGN_EPI) { if (wr == 0) PG8_BAR; }
    PG8_BAR;
#undef PG8_SA
#undef PG8_SB
#undef PG8_STAGE
#undef PG8_LDA
#undef PG8_LDB
#undef PG8_MMA
#undef PG8_WAIT_V
#undef PG8_WAIT_L
#undef PG8_BAR
#undef PG8_SCHED
}

typedef f32x4 Acc[2][2][4][2];

struct EpiSwiGLU {
    bf16_t* O; const u64* ssq;
    __device__ __forceinline__ void operator()(const Acc& acc, const Unit& u, int wr, int wc, int fr, int fq) const {
        const int row0 = u.pm * BM + wr * 64 + fr, col0 = u.pn * 128 + wc * 32 + 8 * fq;
#pragma unroll
        for (int ai = 0; ai < 2; ++ai)
#pragma unroll
            for (int m = 0; m < 4; ++m) {
                asm volatile("" ::: "memory");
                const int r = row0 + ai * HALF + m * 16; const float rs = rstd_of(ssq[r]); const float na = -rs * LOG2E, rs2 = rs * rs;
                const f32x4 g0 = acc[ai][0][m][0], g1 = acc[ai][0][m][1], u0 = acc[ai][1][m][0], u1 = acc[ai][1][m][1];
                const f32x2 oa = swiglu2((f32x2){g0[0], g0[1]}, (f32x2){u0[0], u0[1]}, na, rs2), ob = swiglu2((f32x2){g0[2], g0[3]}, (f32x2){u0[2], u0[3]}, na, rs2);
                const f32x2 oc = swiglu2((f32x2){g1[0], g1[1]}, (f32x2){u1[0], u1[1]}, na, rs2), od = swiglu2((f32x2){g1[2], g1[3]}, (f32x2){u1[2], u1[3]}, na, rs2);
                u32x4 w; w.x = cvt_pk_bf16(oa.x, oa.y); w.y = cvt_pk_bf16(ob.x, ob.y); w.z = cvt_pk_bf16(oc.x, oc.y); w.w = cvt_pk_bf16(od.x, od.y);
                *(u32x4*)(O + (size_t)r * DFF + col0) = w;
            }
    }
};

struct EpiResid {
    bf16_t* HB; bf16_t* H16; u64* ssq_out; int dry;
    __device__ __forceinline__ void operator()(const Acc& acc, const Unit& u, int wr, int wc, int fr, int fq) const {
        const int row0 = u.pm * BM + wr * 64 + fr, col0 = u.pn * BM + wc * 32 + 8 * fq;
#pragma unroll
        for (int ai = 0; ai < 2; ++ai)
#pragma unroll
            for (int m = 0; m < 4; ++m) {
                asm volatile("" ::: "memory");
                const int r = row0 + ai * HALF + m * 16; float part = 0.f;
#pragma unroll
                for (int bj = 0; bj < 2; ++bj) {
                    const size_t off = (size_t)r * D + col0 + bj * HALF;
                    const u32x4 hw = *(const u32x4*)(H16 + off);
                    const f32x2 a = unpk_f16(hw.x), b2 = unpk_f16(hw.y), c = unpk_f16(hw.z), d = unpk_f16(hw.w);
                    f32x4 v0, v1;
                    v0[0] = a.x + acc[ai][bj][m][0][0]; v0[1] = a.y + acc[ai][bj][m][0][1]; v0[2] = b2.x + acc[ai][bj][m][0][2]; v0[3] = b2.y + acc[ai][bj][m][0][3];
                    v1[0] = c.x + acc[ai][bj][m][1][0]; v1[1] = c.y + acc[ai][bj][m][1][1]; v1[2] = d.x + acc[ai][bj][m][1][2]; v1[3] = d.y + acc[ai][bj][m][1][3];
                    u32x4 w; w.x = cvt_pk_bf16(v0[0], v0[1]); w.y = cvt_pk_bf16(v0[2], v0[3]); w.z = cvt_pk_bf16(v1[0], v1[1]); w.w = cvt_pk_bf16(v1[2], v1[3]);
                    u32x4 hq; hq.x = cvt_pk_f16(v0[0], v0[1]); hq.y = cvt_pk_f16(v0[2], v0[3]); hq.z = cvt_pk_f16(v1[0], v1[1]); hq.w = cvt_pk_f16(v1[2], v1[3]);
                    if (!dry) { *(u32x4*)(HB + off) = w; *(u32x4*)(H16 + off) = hq; }
                    part += v0[0] * v0[0] + v0[1] * v0[1] + v0[2] * v0[2] + v0[3] * v0[3] + v1[0] * v1[0] + v1[1] * v1[1] + v1[2] * v1[2] + v1[3] * v1[3];
                }
                part += __shfl_xor(part, 16); part += __shfl_xor(part, 32);
                if (fq == 0 && !dry) atomicAdd(ssq_out + r, ssq_fix(part));
            }
    }
};

struct EpiRowScale {
    bf16_t* O; int ldc; const u64* ssq;
    __device__ __forceinline__ void operator()(const Acc& acc, const Unit& u, int wr, int wc, int fr, int fq) const {
        const int row0 = u.pm * BM + wr * 64 + fr, col0 = u.pn * BM + wc * 32 + 8 * fq;
#pragma unroll
        for (int ai = 0; ai < 2; ++ai)
#pragma unroll
            for (int m = 0; m < 4; ++m) {
                asm volatile("" ::: "memory");
                const int r = row0 + ai * HALF + m * 16; const float rs = rstd_of(ssq[r]);
#pragma unroll
                for (int bj = 0; bj < 2; ++bj) {
                    const f32x4 v0 = acc[ai][bj][m][0] * rs, v1 = acc[ai][bj][m][1] * rs;
                    u32x4 w; w.x = cvt_pk_bf16(v0[0], v0[1]); w.y = cvt_pk_bf16(v0[2], v0[3]); w.z = cvt_pk_bf16(v1[0], v1[1]); w.w = cvt_pk_bf16(v1[2], v1[3]);
                    *(u32x4*)(O + (size_t)r * ldc + col0 + bj * HALF) = w;
                }
            }
    }
};

struct EpiWin {
    unsigned char* ws; const u64* ssq;
    __device__ __forceinline__ void operator()(const Acc& acc, const Unit& u, int wr, int wc, int fr, int fq) const {
        const int pn = u.pn; const int row0 = u.pm * BM + wr * 64 + fr;
        bf16_t* base; int ldc, colt, act = 0;
        if (pn < 4) { base = (bf16_t*)(ws + Z_U); ldc = 1024; colt = pn * 256; act = 1; }
        else if (pn < 8) { base = (bf16_t*)(ws + Z_V); ldc = 1024; colt = (pn - 4) * 256; act = 1; }
        else if (pn < 12) { base = (bf16_t*)(ws + Z_FQ); ldc = 1024; colt = (pn - 8) * 256; }
        else if (pn < 16) { base = (bf16_t*)(ws + Z_FK); ldc = 1024; colt = (pn - 12) * 256; }
        else if (pn < 20) { base = (bf16_t*)(ws + Z_FV); ldc = 1024; colt = (pn - 16) * 256; }
        else if (pn < 22) { base = (bf16_t*)(ws + Z_GQ); ldc = 512; colt = (pn - 20) * 256; }
        else if (pn < 24) { base = (bf16_t*)(ws + Z_GK); ldc = 512; colt = (pn - 22) * 256; }
        else if (pn < 28) { base = (bf16_t*)(ws + Z_GV); ldc = 1024; colt = (pn - 24) * 256; }
        else if (pn < 32) { base = (bf16_t*)(ws + Z_GR); ldc = 1024; colt = (pn - 28) * 256; }
        else { base = (bf16_t*)(ws + Z_GATES); ldc = 6144; colt = (pn - 32) * 256; act = 2; }
        const int col0 = colt + wc * 32 + 8 * fq;
#pragma unroll
        for (int ai = 0; ai < 2; ++ai)
#pragma unroll
            for (int m = 0; m < 4; ++m) {
                asm volatile("" ::: "memory");
                const int r = row0 + ai * HALF + m * 16; const float rs = rstd_of(ssq[r]);
#pragma unroll
                for (int bj = 0; bj < 2; ++bj) {
                    const f32x4 x0 = acc[ai][bj][m][0], x1 = acc[ai][bj][m][1];
                    f32x2 a, b, c, d;
                    if (act == 1) { a = gelu2((f32x2){x0[0], x0[1]}, rs); b = gelu2((f32x2){x0[2], x0[3]}, rs); c = gelu2((f32x2){x1[0], x1[1]}, rs); d = gelu2((f32x2){x1[2], x1[3]}, rs); }
                    else if (act == 2) { const float na = -rs * LOG2E; a = sigmoid2((f32x2){x0[0], x0[1]}, na); b = sigmoid2((f32x2){x0[2], x0[3]}, na); c = sigmoid2((f32x2){x1[0], x1[1]}, na); d = sigmoid2((f32x2){x1[2], x1[3]}, na); }
                    else { a = (f32x2){x0[0], x0[1]} * rs; b = (f32x2){x0[2], x0[3]} * rs; c = (f32x2){x1[0], x1[1]} * rs; d = (f32x2){x1[2], x1[3]} * rs; }
                    u32x4 w; w.x = cvt_pk_bf16(a.x, a.y); w.y = cvt_pk_bf16(b.x, b.y); w.z = cvt_pk_bf16(c.x, c.y); w.w = cvt_pk_bf16(d.x, d.y);
                    *(u32x4*)(base + (size_t)r * ldc + col0 + bj * HALF) = w;
                }
            }
    }
};

struct EpiBranch {
    const bf16_t* gates; float* M32; bf16_t* MB; bf16_t* MA; int br;
    __device__ __forceinline__ void operator()(const Acc& acc, const Unit& u, int wr, int wc, int fr, int fq) const {
        const int row0 = u.pm * BM + wr * 64 + fr, col0 = u.pn * BM + wc * 32 + 8 * fq;
        bf16_t* M16 = (bf16_t*)M32;
        const bf16_t* prev = (br == 1) ? MA : M16; bf16_t* dst = (br == 0) ? MA : (br == 1) ? M16 : MB;
#pragma unroll
        for (int ai = 0; ai < 2; ++ai)
#pragma unroll
            for (int m = 0; m < 4; ++m) {
                asm volatile("" ::: "memory");
                const int r = row0 + ai * HALF + m * 16;
#pragma unroll
                for (int bj = 0; bj < 2; ++bj) {
                    const int c = col0 + bj * HALF; const size_t off = (size_t)r * D + c;
                    const u32x4 gw = *(const u32x4*)(gates + (size_t)r * 6144 + br * D + c);
                    f32x4 v0, v1;
                    v0[0] = acc[ai][bj][m][0][0] * bflo(gw.x); v0[1] = acc[ai][bj][m][0][1] * bfhi(gw.x); v0[2] = acc[ai][bj][m][0][2] * bflo(gw.y); v0[3] = acc[ai][bj][m][0][3] * bfhi(gw.y);
                    v1[0] = acc[ai][bj][m][1][0] * bflo(gw.z); v1[1] = acc[ai][bj][m][1][1] * bfhi(gw.z); v1[2] = acc[ai][bj][m][1][2] * bflo(gw.w); v1[3] = acc[ai][bj][m][1][3] * bfhi(gw.w);
                    if (br > 0) { const u32x4 ma = *(const u32x4*)(prev + off);
                        v0[0] += bflo(ma.x); v0[1] += bfhi(ma.x); v0[2] += bflo(ma.y); v0[3] += bfhi(ma.y); v1[0] += bflo(ma.z); v1[1] += bfhi(ma.z); v1[2] += bflo(ma.w); v1[3] += bfhi(ma.w); }
                    u32x4 w; w.x = cvt_pk_bf16(v0[0], v0[1]); w.y = cvt_pk_bf16(v0[2], v0[3]); w.z = cvt_pk_bf16(v1[0], v1[1]); w.w = cvt_pk_bf16(v1[2], v1[3]);
                    *(u32x4*)(dst + off) = w;
                }
            }
    }
};
}

__device__ __forceinline__ f32x4 mfma16(bf16x8 a, bf16x8 b, f32x4 c) { return __builtin_amdgcn_mfma_f32_16x16x32_bf16(a, b, c, 0, 0, 0); }
__device__ __forceinline__ bf16x8 mk8(unsigned a, unsigned b, unsigned c, unsigned d) { u32x4 v; v.x = a; v.y = b; v.z = c; v.w = d; return __builtin_bit_cast(bf16x8, v); }
__device__ __forceinline__ float wave_sum(float v) {
#pragma unroll
    for (int d = 1; d < 64; d <<= 1) v += __shfl_xor(v, d);
    return v;
}

template <int KIND> __device__ __forceinline__ int map_col(int n, float& sc) {
    sc = 1.f;
    if (KIND == 0) return n;
    if (KIND == 1) { const int pn = n >> 8, r = n & 255; return (r < 128) ? (pn * 128 + r) : (DFF + pn * 128 + (r - 128)); }
    if (n < 2048) return n;
    if (n < 3072) { sc = 0.08838834764831845f * LOG2E; return n; }
    if (n < 5120) return n;
    if (n < 5632) { sc = 0.08838834764831845f; return 5128 + (n - 5120); }
    if (n < 6144) return 5640 + (n - 5632);
    if (n < 7168) return 6152 + (n - 6144);
    if (n < 8192) return 7192 + (n - 7168);
    if (n < 14336) return 8216 + (n - 8192);
    n -= 14336;
    if (n < 8) return 5120 + n;
    if (n < 24) return 7176 + (n - 8);
    return -1;
}

template <int KIND>
__device__ __forceinline__ void prep_job(LAS unsigned char* lds, const float* W, int K, int Nsrc, bf16_t* Bt, int Ndst, const float* gain, float scale, int& base, int G, int w) {
    int tid_ = threadIdx.x; asm volatile("" : "+v"(tid_));
    const int tid = tid_;
    const int ntk = K / 64, ntiles = (Ndst / 256) * ntk;
    asm volatile("" : "+s"(w));
    const int t0 = ((w - base) % G + G) % G;
    base += ntiles;
    LAS bf16_t* tl = (LAS bf16_t*)lds;
    const int n4 = (tid & 63) * 4, kk = tid >> 6;
    for (int t = t0; t < ntiles; t += G) {
        const int tn = t / ntk, tk = t - tn * ntk, n0 = tn * 256, k0 = tk * 64;
        float sc; const int src = map_col<KIND>(n0 + n4, sc); sc *= scale;
        f32x4 v[8];
#pragma unroll
        for (int i = 0; i < 8; ++i) v[i] = (src >= 0) ? *(const f32x4*)(W + (size_t)(k0 + i * 8 + kk) * Nsrc + src) : (f32x4){0.f, 0.f, 0.f, 0.f};
#pragma unroll
        for (int i = 0; i < 8; ++i) {
            const int k = i * 8 + kk; const float gs = sc * (gain ? gain[k0 + k] : 1.f);
            LAS unsigned* p = (LAS unsigned*)(tl + k * 258 + n4);
            p[0] = cvt_pk_bf16(v[i][0] * gs, v[i][1] * gs); p[1] = cvt_pk_bf16(v[i][2] * gs, v[i][3] * gs);
        }
        __syncthreads();
#pragma unroll
        for (int i = 0; i < 4; ++i) {
            const int ch = i * 512 + tid, n = ch >> 3, kc = (ch & 7) * 8;
            const LAS bf16_t* q = tl + kc * 258 + n;
            u32x4 d;
            d.x = (unsigned)q[0 * 258] | ((unsigned)q[1 * 258] << 16); d.y = (unsigned)q[2 * 258] | ((unsigned)q[3 * 258] << 16);
            d.z = (unsigned)q[4 * 258] | ((unsigned)q[5 * 258] << 16); d.w = (unsigned)q[6 * 258] | ((unsigned)q[7 * 258] << 16);
            *(u32x4*)(Bt + (size_t)(n0 + n) * K + k0 + kc) = d;
        }
        __syncthreads();
    }
}

__device__ __forceinline__ void rows_to_bf16(const float* X, bf16_t* XB, bf16_t* X16, u64* ssq, int rows, int gw, int nw) {
    int tid_ = threadIdx.x; asm volatile("" : "+v"(tid_)); asm volatile("" : "+v"(gw));
    const int lane = tid_ & 63;
    for (int r = gw; r < rows; r += nw) {
        const float* xr = X + (size_t)r * D; bf16_t* br = XB + (size_t)r * D; float ss = 0.f;
#pragma unroll
        for (int i = 0; i < 8; ++i) {
            const f32x4 v = *(const f32x4*)(xr + (i * 64 + lane) * 4);
            ss += v[0] * v[0] + v[1] * v[1] + v[2] * v[2] + v[3] * v[3];
            u32x2 w; w.x = cvt_pk_bf16(v[0], v[1]); w.y = cvt_pk_bf16(v[2], v[3]);
            *(u32x2*)(br + (i * 64 + lane) * 4) = w;
            if (X16) { u32x2 hq; hq.x = cvt_pk_f16(v[0], v[1]); hq.y = cvt_pk_f16(v[2], v[3]); *(u32x2*)(X16 + (size_t)r * D + (i * 64 + lane) * 4) = hq; }
        }
        ss = wave_sum(ss);
        if (lane == 0) ssq[r] = ssq_fix(ss);
    }
}

__device__ __forceinline__ void narrow_cols_unit(LAS unsigned char* lds, int rb, const bf16_t* HB, const bf16_t* Btn, const u64* ssq, const float* b_f, float* LOGF, float* GA) {
    int tid_ = threadIdx.x; asm volatile("" : "+v"(tid_));
    const int tid = tid_, wid = __builtin_amdgcn_readfirstlane(tid >> 6), lane = tid & 63, fr = lane & 15, fq = lane >> 4, rg = wid & 3, kh = wid >> 2;
    const bf16_t* arow = HB + (size_t)(rb * 64 + rg * 16 + fr) * D + kh * 1024 + fq * 8;
    const bf16_t* b0 = Btn + (size_t)fr * D + kh * 1024 + fq * 8;
    const bf16_t* b1 = Btn + (size_t)(16 + fr) * D + kh * 1024 + fq * 8;
    f32x4 acc0 = (f32x4){0.f, 0.f, 0.f, 0.f}, acc1 = acc0;
#pragma unroll 8
    for (int ks = 0; ks < 32; ++ks) {
        const bf16x8 af = *(const bf16x8*)(arow + ks * 32), bf0 = *(const bf16x8*)(b0 + ks * 32), bf1 = *(const bf16x8*)(b1 + ks * 32);
        acc0 = mfma16(bf0, af, acc0); acc1 = mfma16(bf1, af, acc1);
    }
    LAS f32x4* red = (LAS f32x4*)lds;
    __syncthreads();
    if (kh == 1) { red[(rg * 2 + 0) * 64 + lane] = acc0; red[(rg * 2 + 1) * 64 + lane] = acc1; }
    __syncthreads();
    if (kh == 0) {
        acc0 += red[(rg * 2 + 0) * 64 + lane]; acc1 += red[(rg * 2 + 1) * 64 + lane];
        const int r = rb * 64 + rg * 16 + fr; const float rs = rstd_of(ssq[r]);
        if (fq < 2) {
            const f32x4 bf = *(const f32x4*)(b_f + fq * 4); f32x4 v;
#pragma unroll
            for (int e = 0; e < 4; ++e) v[e] = logsigmoidf_(acc0[e] * rs + bf[e]);
            *(f32x4*)(LOGF + (size_t)r * 8 + fq * 4) = v;
            *(f32x4*)(GA + (size_t)r * 16 + 8 + fq * 4) = acc1 * rs;
        } else {
            *(f32x4*)(GA + (size_t)r * 16 + (fq - 2) * 4) = acc0 * rs;
        }
    }
}

template <bool FOX>
__device__ __forceinline__ void attn_tile(LAS bf16_t* Ks, LAS bf16_t* Vt, LAS float* cum, int j, bool diag, int fr, int fq, const int (&qpos)[2], const float (&cq)[2],
                                          const bf16x8 (&qf)[2][4], f32x4 (&o)[2][8], float (&m_run)[2], float (&l_run)[2]) {
    f32x4 s[2][4];
#pragma unroll
    for (int mt = 0; mt < 4; ++mt) {
        s[0][mt] = (f32x4){0.f, 0.f, 0.f, 0.f}; s[1][mt] = (f32x4){0.f, 0.f, 0.f, 0.f};
#pragma unroll
        for (int ks = 0; ks < 4; ++ks) { const bf16x8 kf = *(const LAS bf16x8*)(Ks + (mt * 16 + fr) * 136 + ks * 32 + fq * 8); s[0][mt] = mfma16(kf, qf[0][ks], s[0][mt]); s[1][mt] = mfma16(kf, qf[1][ks], s[1][mt]); }
    }
    if (FOX) {
#pragma unroll
        for (int mt = 0; mt < 4; ++mt) { const f32x4 ck = *(const LAS f32x4*)(cum + j * 64 + mt * 16 + fq * 4);
#pragma unroll
            for (int e = 0; e < 4; ++e) { s[0][mt][e] += cq[0] - ck[e]; s[1][mt][e] += cq[1] - ck[e]; } }
        if (diag) {
#pragma unroll
            for (int g = 0; g < 2; ++g)
#pragma unroll
                for (int mt = 0; mt < 4; ++mt)
#pragma unroll
                    for (int e = 0; e < 4; ++e) if (j * 64 + mt * 16 + fq * 4 + e > qpos[g]) s[g][mt][e] = -INFINITY;
        }
    }
    bf16x8 pf[2][2];
#pragma unroll
    for (int g = 0; g < 2; ++g) {
        float mx = -INFINITY;
#pragma unroll
        for (int mt = 0; mt < 4; ++mt)
#pragma unroll
            for (int e = 0; e < 4; ++e) mx = fmaxf(mx, s[g][mt][e]);
        mx = fmaxf(mx, __shfl_xor(mx, 16)); mx = fmaxf(mx, __shfl_xor(mx, 32));
        const float m_new = fmaxf(m_run[g], mx);
        const float alpha = fexp2(m_run[g] - m_new);
        float ls = 0.f;
#pragma unroll
        for (int mt = 0; mt < 4; ++mt)
#pragma unroll
            for (int e = 0; e < 4; ++e) { const float p = fexp2(s[g][mt][e] - m_new); s[g][mt][e] = p; ls += p; }
        l_run[g] = l_run[g] * alpha + ls; m_run[g] = m_new;
#pragma unroll
        for (int i = 0; i < 8; ++i) o[g][i] *= alpha;
#pragma unroll
        for (int i = 0; i < 2; ++i) pf[g][i] = mk8(cvt_pk_bf16(s[g][2 * i][0], s[g][2 * i][1]), cvt_pk_bf16(s[g][2 * i][2], s[g][2 * i][3]), cvt_pk_bf16(s[g][2 * i + 1][0], s[g][2 * i + 1][1]), cvt_pk_bf16(s[g][2 * i + 1][2], s[g][2 * i + 1][3]));
    }
#pragma unroll
    for (int dt = 0; dt < 8; ++dt)
#pragma unroll
        for (int i = 0; i < 2; ++i) {
            const u32x2 lo = *(const LAS u32x2*)(Vt + (dt * 16 + fr) * 72 + i * 32 + fq * 4), hi2 = *(const LAS u32x2*)(Vt + (dt * 16 + fr) * 72 + i * 32 + 16 + fq * 4);
            const bf16x8 vf = mk8(lo.x, lo.y, hi2.x, hi2.y);
            o[0][dt] = mfma16(vf, pf[0][i], o[0][dt]); o[1][dt] = mfma16(vf, pf[1][i], o[1][dt]);
        }
}

template <bool FOX>
__device__ __forceinline__ void attn_unit(LAS unsigned char* lds, const bf16_t* Qp, int ldq, const bf16_t* Kp, const bf16_t* Vp, int ldkv, bf16_t* Op, int ldo,
                                          int ntiles  , int qpos0, const float* logf_bh, bool dry) {
    int tid_ = threadIdx.x; asm volatile("" : "+v"(tid_));
    const int tid = tid_, wid = __builtin_amdgcn_readfirstlane(tid >> 6), lane = tid & 63, fr = lane & 15, fq = lane >> 4;
    LAS bf16_t* Ks0 = (LAS bf16_t*)lds;
    LAS bf16_t* Vt0 = (LAS bf16_t*)(lds + 17408);
    LAS bf16_t* Ks1 = (LAS bf16_t*)(lds + 35840);
    LAS bf16_t* Vt1 = (LAS bf16_t*)(lds + 35840 + 17408);
    LAS float* cum = (LAS float*)(lds + 71680);
    LAS float* wsum = (LAS float*)(lds + 71680 + 8192);
    __syncthreads();
    if (FOX) {
        const int hi = ntiles * 64;
        float a0, a1, a2, a3;
        { const int i0 = 4 * tid; a0 = (i0 < hi) ? logf_bh[(size_t)i0 * 8] : 0.f; a1 = (i0 + 1 < hi) ? logf_bh[(size_t)(i0 + 1) * 8] : 0.f;
          a2 = (i0 + 2 < hi) ? logf_bh[(size_t)(i0 + 2) * 8] : 0.f; a3 = (i0 + 3 < hi) ? logf_bh[(size_t)(i0 + 3) * 8] : 0.f; }
        a1 += a0; a2 += a1; a3 += a2;
        float tot = a3;
#pragma unroll
        for (int d = 1; d < 64; d <<= 1) { const float t = __shfl_up(tot, d); if (lane >= d) tot += t; }
        if (lane == 63) wsum[wid] = tot;
        __syncthreads();
        float basep = 0.f;
        for (int w = 0; w < wid; ++w) basep += wsum[w];
        const float ex = basep + tot - a3;
        cum[4 * tid + 0] = (ex + a0) * LOG2E; cum[4 * tid + 1] = (ex + a1) * LOG2E; cum[4 * tid + 2] = (ex + a2) * LOG2E; cum[4 * tid + 3] = (ex + a3) * LOG2E;
        __syncthreads();
    }
    bf16x8 qf[2][4];
#pragma unroll
    for (int g = 0; g < 2; ++g) { const bf16_t* qrow = Qp + (size_t)(wid * 32 + g * 16 + fr) * ldq;
#pragma unroll
        for (int ks = 0; ks < 4; ++ks) qf[g][ks] = *(const bf16x8*)(qrow + ks * 32 + fq * 8); }
    int qpos[2]; qpos[0] = qpos0 + wid * 32 + fr; qpos[1] = qpos[0] + 16;
    float cq[2]; cq[0] = FOX ? cum[qpos[0]] : 0.f; cq[1] = FOX ? cum[qpos[1]] : 0.f;
    float m_run[2] = {-INFINITY, -INFINITY}, l_run[2] = {0.f, 0.f};
    f32x4 o[2][8];
#pragma unroll
    for (int i = 0; i < 8; ++i) { o[0][i] = (f32x4){0.f, 0.f, 0.f, 0.f}; o[1][i] = (f32x4){0.f, 0.f, 0.f, 0.f}; }
    const int wave_last = qpos0 + wid * 32 + 31;
    u32x4 kA[2], vA[2], kB[2], vB[2];
#define ATT_LOAD(kr, vr, j) do { _Pragma("unroll") for (int i = 0; i < 2; ++i) { const int ch = tid + i * 512; \
        kr[i] = *(const u32x4*)(Kp + (size_t)((j) * 64 + (ch >> 4)) * ldkv + (ch & 15) * 8); \
        vr[i] = *(const u32x4*)(Vp + (size_t)((j) * 64 + lane) * ldkv + (wid + 8 * i) * 8); } } while (0)
#define ATT_STAGE(Ks, Vt, kr, vr) do { _Pragma("unroll") for (int i = 0; i < 2; ++i) { const int ch = tid + i * 512; \
        *(LAS u32x4*)(Ks + (ch >> 4) * 136 + (ch & 15) * 8) = kr[i]; \
        LAS bf16_t* vp = Vt + ((wid + 8 * i) * 8) * 72 + lane; \
        vp[0 * 72] = (bf16_t)(vr[i].x & 0xffffu); vp[1 * 72] = (bf16_t)(vr[i].x >> 16); vp[2 * 72] = (bf16_t)(vr[i].y & 0xffffu); vp[3 * 72] = (bf16_t)(vr[i].y >> 16); \
        vp[4 * 72] = (bf16_t)(vr[i].z & 0xffffu); vp[5 * 72] = (bf16_t)(vr[i].z >> 16); vp[6 * 72] = (bf16_t)(vr[i].w & 0xffffu); vp[7 * 72] = (bf16_t)(vr[i].w >> 16); } } while (0)
    ATT_LOAD(kA, vA, 0); ATT_LOAD(kB, vB, 1);
    ATT_STAGE(Ks0, Vt0, kA, vA);
    if (2 < ntiles) ATT_LOAD(kA, vA, 2);
    __syncthreads();
    for (int j = 0; j < ntiles; j += 2) {
        ATT_STAGE(Ks1, Vt1, kB, vB);
        if (j + 3 < ntiles) ATT_LOAD(kB, vB, j + 3);
        if (!FOX || j * 64 <= wave_last) attn_tile<FOX>(Ks0, Vt0, cum, j, FOX && (j >= ntiles - 4), fr, fq, qpos, cq, qf, o, m_run, l_run);
        __syncthreads();
        if (j + 2 < ntiles) { ATT_STAGE(Ks0, Vt0, kA, vA); }
        if (j + 4 < ntiles) ATT_LOAD(kA, vA, j + 4);
        if (!FOX || (j + 1) * 64 <= wave_last) attn_tile<FOX>(Ks1, Vt1, cum, j + 1, FOX && (j + 1 >= ntiles - 4), fr, fq, qpos, cq, qf, o, m_run, l_run);
        __syncthreads();
    }
#undef ATT_LOAD
#undef ATT_STAGE
#pragma unroll
    for (int g = 0; g < 2; ++g) {
        float l = l_run[g]; l += __shfl_xor(l, 16); l += __shfl_xor(l, 32);
        const float inv = frcp(l);
        bf16_t* orow = Op + (size_t)(wid * 32 + g * 16 + fr) * ldo + fq * 4;
#pragma unroll
        for (int dt = 0; dt < 8; ++dt) { u32x2 w; w.x = cvt_pk_bf16(o[g][dt][0] * inv, o[g][dt][1] * inv); w.y = cvt_pk_bf16(o[g][dt][2] * inv, o[g][dt][3] * inv); if (!dry) *(u32x2*)(orow + dt * 16) = w; }
    }
}

__device__ __forceinline__ void sgu_unit(LAS unsigned char* lds, int b, int n, int g, const bf16_t* V, bf16_t* U, const float* ln_g, const float* ln_b, const float* w_s, const float* b_s, bool dry) {
    int tid_ = threadIdx.x; asm volatile("" : "+v"(tid_));
    const int tid = tid_, wid = tid >> 6, lane = tid & 63, fr = lane & 15, fq = lane >> 4;
    LAS bf16_t* vt = (LAS bf16_t*)lds;
    LAS float* st = (LAS float*)(lds + 69632);
    const int r0 = b * SEQ + n * 128;
    __syncthreads();
    for (int rr = 0; rr < 16; ++rr) {
        const int s = wid * 16 + rr;
        const u32x2 raw = *(const u32x2*)(V + (size_t)(r0 + s) * 1024 + g * 256 + lane * 4);
        const float x0 = bflo(raw.x), x1 = bfhi(raw.x), x2 = bflo(raw.y), x3 = bfhi(raw.y);
        const float mean = wave_sum(x0 + x1 + x2 + x3) * (1.f / 256.f);
        const float d0 = x0 - mean, d1 = x1 - mean, d2 = x2 - mean, d3 = x3 - mean;
        const float var = wave_sum(d0 * d0 + d1 * d1 + d2 * d2 + d3 * d3) * (1.f / 256.f);
        if (lane == 0) { st[2 * s] = mean; st[2 * s + 1] = frsq(var + EPS); }
    }
    __syncthreads();
    {
        const int s = tid & 127, cg0 = (tid >> 7) * 64;
        const float mean = st[2 * s], rstd = st[2 * s + 1];
        const bf16_t* vrow = V + (size_t)(r0 + s) * 1024 + g * 256 + cg0;
#pragma unroll
        for (int i = 0; i < 8; ++i) {
            const u32x4 raw = *(const u32x4*)(vrow + i * 8);
            const f32x4 g0 = *(const f32x4*)(ln_g + g * 256 + cg0 + i * 8), g1 = *(const f32x4*)(ln_g + g * 256 + cg0 + i * 8 + 4);
            const f32x4 b0 = *(const f32x4*)(ln_b + g * 256 + cg0 + i * 8), b1 = *(const f32x4*)(ln_b + g * 256 + cg0 + i * 8 + 4);
            LAS bf16_t* p = vt + (cg0 + i * 8) * 136 + s;
            p[0 * 136] = f2bf((bflo(raw.x) - mean) * rstd * g0[0] + b0[0]); p[1 * 136] = f2bf((bfhi(raw.x) - mean) * rstd * g0[1] + b0[1]);
            p[2 * 136] = f2bf((bflo(raw.y) - mean) * rstd * g0[2] + b0[2]); p[3 * 136] = f2bf((bfhi(raw.y) - mean) * rstd * g0[3] + b0[3]);
            p[4 * 136] = f2bf((bflo(raw.z) - mean) * rstd * g1[0] + b1[0]); p[5 * 136] = f2bf((bfhi(raw.z) - mean) * rstd * g1[1] + b1[1]);
            p[6 * 136] = f2bf((bflo(raw.w) - mean) * rstd * g1[2] + b1[2]); p[7 * 136] = f2bf((bfhi(raw.w) - mean) * rstd * g1[3] + b1[3]);
        }
    }
    __syncthreads();
    f32x4 acc[16];
#pragma unroll
    for (int i = 0; i < 16; ++i) acc[i] = (f32x4){0.f, 0.f, 0.f, 0.f};
    const int t = 16 * wid + fr;
    const int nks = (16 * wid + 15) / 32 + 1;
    for (int ks = 0; ks < nks; ++ks) {
        const float* wp = w_s + ((size_t)g * 128 + t) * 128 + ks * 32 + fq * 8;
        f32x4 w0 = *(const f32x4*)wp, w1 = *(const f32x4*)(wp + 4);
        const int sb = ks * 32 + fq * 8;
#pragma unroll
        for (int e = 0; e < 4; ++e) { if (sb + e > t) w0[e] = 0.f; if (sb + 4 + e > t) w1[e] = 0.f; }
        const bf16x8 wf = mk8(cvt_pk_bf16(w0[0], w0[1]), cvt_pk_bf16(w0[2], w0[3]), cvt_pk_bf16(w1[0], w1[1]), cvt_pk_bf16(w1[2], w1[3]));
#pragma unroll
        for (int nt = 0; nt < 16; ++nt) { const bf16x8 vf = *(const LAS bf16x8*)(vt + (nt * 16 + fr) * 136 + ks * 32 + fq * 8); acc[nt] = mfma16(vf, wf, acc[nt]); }
    }
    const float bs = b_s[g * 128 + t];
    bf16_t* up = U + (size_t)(r0 + t) * 1024 + g * 256 + fq * 4;
#pragma unroll
    for (int nt = 0; nt < 16; ++nt) {
        const u32x2 uu = *(const u32x2*)(up + nt * 16);
        u32x2 w; w.x = cvt_pk_bf16(bflo(uu.x) * (acc[nt][0] + bs), bfhi(uu.x) * (acc[nt][1] + bs)); w.y = cvt_pk_bf16(bflo(uu.y) * (acc[nt][2] + bs), bfhi(uu.y) * (acc[nt][3] + bs));
        if (!dry) *(u32x2*)(up + nt * 16) = w;
    }
}

__device__ __forceinline__ void gla_pre_unit(LAS unsigned char* lds, int b, int h, int ci, unsigned char* ws, const float* w_gate, const float* b_gate) {
    int tid_ = threadIdx.x; asm volatile("" : "+v"(tid_));
    const int tid = tid_, wid = tid >> 6, lane = tid & 63, fr = lane & 15, fq = lane >> 4;
    LAS bf16_t* QT = (LAS bf16_t*)lds;
    LAS bf16_t* KT = (LAS bf16_t*)(lds + 17408);
    LAS bf16_t* QD = (LAS bf16_t*)(lds + 34816);
    LAS bf16_t* KDT = (LAS bf16_t*)(lds + 52224);
    LAS bf16_t* VT = (LAS bf16_t*)(lds + 70656);
    LAS bf16_t* ATT = (LAS bf16_t*)(lds + 107520);
    LAS float* GAL = (LAS float*)(lds + 116736);
    LAS float* SEGTOT = (LAS float*)(lds + 120832);
    LAS float* BFIRST = (LAS float*)(lds + 122880);
    LAS float* DECAY = (LAS float*)(lds + 123392);
    const bf16_t* GQ = (const bf16_t*)(ws + Z_GQ); const bf16_t* GK = (const bf16_t*)(ws + Z_GK); const bf16_t* GV = (const bf16_t*)(ws + Z_GV);
    const float* GA = (const float*)(ws + WS_GA);
    const int unit = (b * 4 + h) * 32 + ci;
    bf16_t* OI = (bf16_t*)(ws + WS_OI) + (size_t)unit * 16384;
    bf16_t* UC = (bf16_t*)(ws + WS_UC) + (size_t)unit * 32768;
    bf16_t* QDF = (bf16_t*)(ws + WS_QDF) + (size_t)unit * 8192;
    float* DEC = (float*)(ws + WS_DEC) + (size_t)unit * 128;
    const int c = tid & 127, seg = tid >> 7;
    const int rc = b * SEQ + ci * 64;
    __syncthreads();
    if (tid < 256) *(LAS f32x4*)(GAL + tid * 4) = *(const f32x4*)(GA + (size_t)rc * 16 + tid * 4);
#pragma unroll
    for (int i = 0; i < 4; ++i) {
        const int vc = (wid + 8 * i) * 8;
        const u32x4 raw = *(const u32x4*)(GV + (size_t)(rc + lane) * 1024 + h * 256 + vc);
        LAS bf16_t* vp = VT + vc * 72 + lane;
        vp[0 * 72] = (bf16_t)(raw.x & 0xffffu); vp[1 * 72] = (bf16_t)(raw.x >> 16); vp[2 * 72] = (bf16_t)(raw.y & 0xffffu); vp[3 * 72] = (bf16_t)(raw.y >> 16);
        vp[4 * 72] = (bf16_t)(raw.z & 0xffffu); vp[5 * 72] = (bf16_t)(raw.z >> 16); vp[6 * 72] = (bf16_t)(raw.w & 0xffffu); vp[7 * 72] = (bf16_t)(raw.w >> 16);
    }
    float wg[16];
#pragma unroll
    for (int j = 0; j < 16; ++j) wg[j] = w_gate[j * 512 + h * 128 + c];
    const float bg = b_gate[h * 128 + c];
    unsigned short qraw[16], kraw[16];
#pragma unroll
    for (int tt = 0; tt < 16; ++tt) { const int t = seg * 16 + tt; qraw[tt] = GQ[(size_t)(rc + t) * 512 + h * 128 + c]; kraw[tt] = GK[(size_t)(rc + t) * 512 + h * 128 + c]; }
    __syncthreads();
    float bc[16]; float run = 0.f;
#pragma unroll
    for (int tt = 0; tt < 16; ++tt) {
        const int t = seg * 16 + tt; float x = bg;
#pragma unroll
        for (int j4 = 0; j4 < 4; ++j4) { const f32x4 a = *(const LAS f32x4*)(GAL + t * 16 + j4 * 4); x += a[0] * wg[j4 * 4] + a[1] * wg[j4 * 4 + 1] + a[2] * wg[j4 * 4 + 2] + a[3] * wg[j4 * 4 + 3]; }
        run += logsigmoidf_(x) * (1.f / 16.f); bc[tt] = run;
    }
    SEGTOT[seg * 128 + c] = run; if (seg == 2) BFIRST[c] = bc[0];
    __syncthreads();
    {
        const float s0 = SEGTOT[c], s1 = SEGTOT[128 + c], s2 = SEGTOT[256 + c], s3 = SEGTOT[384 + c];
        const float offs = (seg == 0) ? 0.f : (seg == 1) ? s0 : (seg == 2) ? (s0 + s1) : (s0 + s1 + s2);
        const float blast = s0 + s1 + s2 + s3, bref = s0 + s1 + BFIRST[c];
        if (seg == 0) DECAY[c] = fexp2(blast * LOG2E);
#pragma unroll
        for (int tt = 0; tt < 16; ++tt) {
            const int t = seg * 16 + tt; const float B = offs + bc[tt];
            const float qv = bf2f(qraw[tt]), kv = bf2f(kraw[tt]);
            QT[t * 136 + c] = f2bf(qv * fexp2((B - bref) * LOG2E)); KT[t * 136 + c] = f2bf(kv * fexp2((bref - B) * LOG2E));
            QD[t * 136 + c] = f2bf(qv * fexp2(B * LOG2E)); KDT[c * 72 + t] = f2bf(kv * fexp2((blast - B) * LOG2E));
        }
    }
    __syncthreads();
#pragma unroll
    for (int q = 0; q < 2; ++q) {
        const int id = wid * 2 + q, tm = id >> 2, sn = id & 3;
        f32x4 a = (f32x4){0.f, 0.f, 0.f, 0.f};
        if (sn <= tm) {
#pragma unroll
            for (int ks = 0; ks < 4; ++ks) { const bf16x8 kf = *(const LAS bf16x8*)(KT + (sn * 16 + fr) * 136 + ks * 32 + fq * 8), qf = *(const LAS bf16x8*)(QT + (tm * 16 + fr) * 136 + ks * 32 + fq * 8); a = mfma16(kf, qf, a); }
            if (sn == tm) {
#pragma unroll
                for (int e = 0; e < 4; ++e) if (fq * 4 + e > fr) a[e] = 0.f;
            }
        }
        u32x2 w; w.x = cvt_pk_bf16(a[0], a[1]); w.y = cvt_pk_bf16(a[2], a[3]);
        *(LAS u32x2*)(ATT + (tm * 16 + fr) * 72 + sn * 16 + fq * 4) = w;
    }
#pragma unroll
    for (int j = 0; j < 2; ++j) {
        const int id = tid + 512 * j, pair = id >> 6, tt = pair >> 2, i = pair & 3, ln = id & 63, fr2 = ln & 15, fq2 = ln >> 4;
        const u32x2 lo = *(const LAS u32x2*)(QD + (tt * 16 + fr2) * 136 + 32 * i + fq2 * 4), hi2 = *(const LAS u32x2*)(QD + (tt * 16 + fr2) * 136 + 32 * i + 16 + fq2 * 4);
        u32x4 w; w.x = lo.x; w.y = lo.y; w.z = hi2.x; w.w = hi2.y;
        *(u32x4*)(QDF + (size_t)id * 8) = w;
    }
    if (tid < 128) DEC[tid] = DECAY[tid];
    __syncthreads();
    {
        f32x4 o[2][4];
#pragma unroll
        for (int vt = 0; vt < 2; ++vt)
#pragma unroll
            for (int tt = 0; tt < 4; ++tt) o[vt][tt] = (f32x4){0.f, 0.f, 0.f, 0.f};
#pragma unroll
        for (int ks = 0; ks < 2; ++ks) {
            const bf16x8 vf0 = *(const LAS bf16x8*)(VT + (32 * wid + fr) * 72 + ks * 32 + fq * 8), vf1 = *(const LAS bf16x8*)(VT + (32 * wid + 16 + fr) * 72 + ks * 32 + fq * 8);
#pragma unroll
            for (int tt = 0; tt < 4; ++tt) {
                if (tt * 16 + 15 >= ks * 32) {
                    const bf16x8 af = *(const LAS bf16x8*)(ATT + (tt * 16 + fr) * 72 + ks * 32 + fq * 8);
                    o[0][tt] = mfma16(vf0, af, o[0][tt]); o[1][tt] = mfma16(vf1, af, o[1][tt]);
                }
            }
        }
#pragma unroll
        for (int tt = 0; tt < 4; ++tt) {
            u32x4 w; w.x = cvt_pk_bf16(o[0][tt][0], o[0][tt][1]); w.y = cvt_pk_bf16(o[0][tt][2], o[0][tt][3]); w.z = cvt_pk_bf16(o[1][tt][0], o[1][tt][1]); w.w = cvt_pk_bf16(o[1][tt][2], o[1][tt][3]);
            *(u32x4*)(OI + ((wid * 4 + tt) * 64 + lane) * 8) = w;
        }
    }
    {
        const bf16x8 vf00 = *(const LAS bf16x8*)(VT + (32 * wid + fr) * 72 + fq * 8), vf01 = *(const LAS bf16x8*)(VT + (32 * wid + fr) * 72 + 32 + fq * 8);
        const bf16x8 vf10 = *(const LAS bf16x8*)(VT + (32 * wid + 16 + fr) * 72 + fq * 8), vf11 = *(const LAS bf16x8*)(VT + (32 * wid + 16 + fr) * 72 + 32 + fq * 8);
#pragma unroll
        for (int mt = 0; mt < 8; ++mt) {
            const bf16x8 kf0 = *(const LAS bf16x8*)(KDT + (mt * 16 + fr) * 72 + fq * 8), kf1 = *(const LAS bf16x8*)(KDT + (mt * 16 + fr) * 72 + 32 + fq * 8);
            f32x4 u0 = (f32x4){0.f, 0.f, 0.f, 0.f}, u1 = u0;
            u0 = mfma16(kf0, vf00, u0); u0 = mfma16(kf1, vf01, u0);
            u1 = mfma16(kf0, vf10, u1); u1 = mfma16(kf1, vf11, u1);
            u32x4 w; w.x = cvt_pk_bf16(u0[0], u0[1]); w.y = cvt_pk_bf16(u0[2], u0[3]); w.z = cvt_pk_bf16(u1[0], u1[1]); w.w = cvt_pk_bf16(u1[2], u1[3]);
            *(u32x4*)(UC + ((wid * 8 + mt) * 64 + lane) * 8) = w;
        }
    }
}

__device__ __forceinline__ void gla_seq_unit(LAS unsigned char* lds, int b, int h, unsigned char* ws, const float* o_norm, bool dry) {
    int tid_ = threadIdx.x; asm volatile("" : "+v"(tid_));
    const int tid = tid_, wid = __builtin_amdgcn_readfirstlane(tid >> 6), lane = tid & 63, fr = lane & 15, fq = lane >> 4;
    LAS float* PART = (LAS float*)lds;
    LAS bf16_t* QDFL = (LAS bf16_t*)(lds + 2048);
    LAS float* DECL = (LAS float*)(lds + 2048 + 16384);
    bf16_t* GR = (bf16_t*)(ws + Z_GR);
    f32x4 S[8][2];
#pragma unroll
    for (int i = 0; i < 8; ++i) { S[i][0] = (f32x4){0.f, 0.f, 0.f, 0.f}; S[i][1] = (f32x4){0.f, 0.f, 0.f, 0.f}; }
    u32x4 ucp[8];
    { const bf16_t* UC0 = (const bf16_t*)(ws + WS_UC) + (size_t)((b * 4 + h) * 32) * 32768;
#pragma unroll
      for (int mt = 0; mt < 6; ++mt) ucp[mt] = *(const u32x4*)(UC0 + ((wid * 8 + mt) * 64 + lane) * 8); }
    for (int ci = 0; ci < 32; ++ci) {
        asm volatile("" ::: "memory");
        const int unit = (b * 4 + h) * 32 + ci, rc = b * SEQ + ci * 64;
        const bf16_t* OI = (const bf16_t*)(ws + WS_OI) + (size_t)unit * 16384;
        const bf16_t* UC = (const bf16_t*)(ws + WS_UC) + (size_t)unit * 32768;
        const bf16_t* QDF = (const bf16_t*)(ws + WS_QDF) + (size_t)unit * 8192;
        const float* DEC = (const float*)(ws + WS_DEC) + (size_t)unit * 128;
        const u32x4 qst0 = *(const u32x4*)(QDF + tid * 8), qst1 = *(const u32x4*)(QDF + (tid + 512) * 8);
        const float dst = DEC[tid & 127];
        u32x2 rr8[4][2];
#pragma unroll
        for (int tt = 0; tt < 4; ++tt)
#pragma unroll
            for (int vt = 0; vt < 2; ++vt) rr8[tt][vt] = *(const u32x2*)(GR + (size_t)(rc + tt * 16 + fr) * 1024 + h * 256 + 32 * wid + vt * 16 + fq * 4);
        ucp[6] = *(const u32x4*)(UC + ((wid * 8 + 6) * 64 + lane) * 8); ucp[7] = *(const u32x4*)(UC + ((wid * 8 + 7) * 64 + lane) * 8);
        u32x4 oip[4];
#pragma unroll
        for (int tt = 0; tt < 4; ++tt) oip[tt] = *(const u32x4*)(OI + ((wid * 4 + tt) * 64 + lane) * 8);
        __syncthreads();
        *(LAS u32x4*)(QDFL + tid * 8) = qst0; *(LAS u32x4*)(QDFL + (tid + 512) * 8) = qst1; if (tid < 128) DECL[tid] = dst;
        __syncthreads();
        f32x4 o[2][4];
#pragma unroll
        for (int tt = 0; tt < 4; ++tt) {
            o[0][tt][0] = bflo(oip[tt].x); o[0][tt][1] = bfhi(oip[tt].x); o[0][tt][2] = bflo(oip[tt].y); o[0][tt][3] = bfhi(oip[tt].y);
            o[1][tt][0] = bflo(oip[tt].z); o[1][tt][1] = bfhi(oip[tt].z); o[1][tt][2] = bflo(oip[tt].w); o[1][tt][3] = bfhi(oip[tt].w);
        }
#pragma unroll
        for (int i = 0; i < 4; ++i) {
            bf16x8 sf[2];
#pragma unroll
            for (int vt = 0; vt < 2; ++vt) sf[vt] = mk8(cvt_pk_bf16(S[2 * i][vt][0], S[2 * i][vt][1]), cvt_pk_bf16(S[2 * i][vt][2], S[2 * i][vt][3]), cvt_pk_bf16(S[2 * i + 1][vt][0], S[2 * i + 1][vt][1]), cvt_pk_bf16(S[2 * i + 1][vt][2], S[2 * i + 1][vt][3]));
#pragma unroll
            for (int tt = 0; tt < 4; ++tt) {
                const bf16x8 qf = *(const LAS bf16x8*)(QDFL + (tt * 4 + i) * 512 + lane * 8);
                o[0][tt] = mfma16(sf[0], qf, o[0][tt]); o[1][tt] = mfma16(sf[1], qf, o[1][tt]);
            }
        }
#pragma unroll
        for (int mt = 0; mt < 8; ++mt) {
            const f32x4 dec = *(const LAS f32x4*)(DECL + mt * 16 + fq * 4);
            f32x4 u0, u1; u0[0] = bflo(ucp[mt].x); u0[1] = bfhi(ucp[mt].x); u0[2] = bflo(ucp[mt].y); u0[3] = bfhi(ucp[mt].y); u1[0] = bflo(ucp[mt].z); u1[1] = bfhi(ucp[mt].z); u1[2] = bflo(ucp[mt].w); u1[3] = bfhi(ucp[mt].w);
            S[mt][0] = S[mt][0] * dec + u0; S[mt][1] = S[mt][1] * dec + u1;
        }
        asm volatile("" ::: "memory");
        { const bf16_t* UCn = UC + ((ci + 1 < 32) ? 32768 : 0);
#pragma unroll
          for (int mt = 0; mt < 6; ++mt) ucp[mt] = *(const u32x4*)(UCn + ((wid * 8 + mt) * 64 + lane) * 8); }
#pragma unroll
        for (int tt = 0; tt < 4; ++tt) {
            float p = 0.f;
#pragma unroll
            for (int vt = 0; vt < 2; ++vt)
#pragma unroll
                for (int e = 0; e < 4; ++e) p += o[vt][tt][e] * o[vt][tt][e];
            p += __shfl_xor(p, 16); p += __shfl_xor(p, 32);
            if (fq == 0) PART[wid * 64 + tt * 16 + fr] = p;
        }
        __syncthreads();
#pragma unroll
        for (int tt = 0; tt < 4; ++tt) {
            const int t = tt * 16 + fr; float tot = 0.f;
#pragma unroll
            for (int w = 0; w < 8; ++w) tot += PART[w * 64 + t];
            const float rs = frsq(tot * (1.f / 256.f) + EPS);
#pragma unroll
            for (int vt = 0; vt < 2; ++vt) {
                const int vcol = 32 * wid + vt * 16 + fq * 4;
                bf16_t* rp = GR + (size_t)(rc + t) * 1024 + h * 256 + vcol;
                const u32x2 rr = rr8[tt][vt]; const f32x4 on = *(const f32x4*)(o_norm + h * 256 + vcol);
                u32x2 w; w.x = cvt_pk_bf16(o[vt][tt][0] * rs * on[0] * siluf_(bflo(rr.x)), o[vt][tt][1] * rs * on[1] * siluf_(bfhi(rr.x)));
                w.y = cvt_pk_bf16(o[vt][tt][2] * rs * on[2] * siluf_(bflo(rr.y)), o[vt][tt][3] * rs * on[3] * siluf_(bfhi(rr.y)));
                if (!dry) *(u32x2*)rp = w;
            }
        }
    }
}
struct Args { const float* in[28]; float* out; unsigned char* ws; int ph_lo, ph_hi; };
constexpr int N_PHASES = 27;
constexpr int NPL = 13;


#define XB_TMO      128
#define XB_XCNT(j)  (256  + 64 * (j))
#define XB_XSUB(j)  (1280 + 64 * (j))
#define XB_XGEN(j)  (2304 + 64 * (j))
#define XB_TOP      3328
#define XB_TOPGEN   3392
#define XCD_BAR_WORDS 3456
#define XB_SPIN_CAP (1u << 18)
__device__ __forceinline__ unsigned xb_ld(unsigned* p)              { return __hip_atomic_load(p, __ATOMIC_RELAXED, __HIP_MEMORY_SCOPE_AGENT); }
__device__ __forceinline__ unsigned xb_add(unsigned* p, unsigned v) { return __hip_atomic_fetch_add(p, v, __ATOMIC_RELAXED, __HIP_MEMORY_SCOPE_AGENT); }
__device__ __forceinline__ unsigned xb_xcc_id() { return (unsigned)__builtin_amdgcn_s_getreg((3 << 11) | 20) & 0xFu; }
#define XB_SPIN(cond, bar) do { unsigned _sp = 0; while (cond) { __builtin_amdgcn_s_sleep(1); \
    if ((++_sp & 255u) == 0u) { if (xb_ld(&(bar)[XB_TMO])) break; if (_sp > XB_SPIN_CAP) { atomicAdd(&(bar)[XB_TMO], 1u); break; } } } } while (0)
__device__ __forceinline__ void xcd_barrier_complete(unsigned* bar, unsigned x, unsigned G, unsigned& nloc, unsigned& nx) {
    unsigned sum, cnt, mine, sp = 0u;
    for (;;) {
        sum = 0u; cnt = 0u; mine = 0u;
#pragma unroll
        for (unsigned j = 0; j < 16; ++j) { const unsigned c = xb_ld(&bar[XB_XCNT(j)]); sum += c; cnt += (c > 0u) ? 1u : 0u; mine = (j == x) ? c : mine; }
        if (sum == G) break;
        __builtin_amdgcn_s_sleep(1);
        if ((++sp & 255u) == 0u) { if (xb_ld(&bar[XB_TMO])) break; if (sp > XB_SPIN_CAP) { atomicAdd(&bar[XB_TMO], 1u); break; } }
    }
    nloc = mine > 0u ? mine : 1u; nx = cnt > 0u ? cnt : 1u;
}
__device__ __forceinline__ void xcd_barrier(unsigned* bar, volatile LAS unsigned* st, bool tid0, unsigned G) {
    asm volatile("s_waitcnt vmcnt(0)" ::: "memory");
    __syncthreads();
    if (tid0) {
        const unsigned x = xb_xcc_id();
        __builtin_amdgcn_s_waitcnt(0);
        unsigned nloc = st[0], nx = st[1];
        if (nloc == 0u) { xcd_barrier_complete(bar, x, G, nloc, nx); st[0] = nloc; st[1] = nx; }
        const unsigned old = xb_add(&bar[XB_XSUB(x)], 1u);
        const unsigned gen = old / nloc;
        if (old + 1u == (gen + 1u) * nloc) {
            __builtin_amdgcn_fence(__ATOMIC_RELEASE, "agent");
            asm volatile("s_waitcnt vmcnt(0)" ::: "memory");
            const unsigned og = xb_add(&bar[XB_TOP], 1u);
            const unsigned tg = og / nx;
            if (og + 1u == (tg + 1u) * nx) xb_add(&bar[XB_TOPGEN], 1u);
            else XB_SPIN(xb_ld(&bar[XB_TOPGEN]) == tg, bar);
            __builtin_amdgcn_fence(__ATOMIC_ACQUIRE, "agent");
            xb_add(&bar[XB_XGEN(x)], 1u);
            asm volatile("s_waitcnt vmcnt(0)" ::: "memory");
        } else {
            XB_SPIN(xb_ld(&bar[XB_XGEN(x)]) == gen, bar);
            __builtin_amdgcn_fence(__ATOMIC_ACQUIRE, "agent");
            asm volatile("s_waitcnt vmcnt(0)" ::: "memory");
        }
    }
    __syncthreads();
}

__device__ __forceinline__ int queue_pop(unsigned* ctr, LAS int* slot) {
    int tid_ = threadIdx.x; asm volatile("" : "+v"(tid_));
    __syncthreads();
    if (tid_ == 0) *slot = (int)atomicAdd(ctr, 1u);
    __syncthreads();
    return *slot;
}

__global__ void __launch_bounds__(NTHREADS, 2) fwd_kernel(Args a) {
    extern __shared__ __attribute__((aligned(16))) unsigned char lds_raw[];
    LAS unsigned char* lds = (LAS unsigned char*)lds_raw;
    typedef const __attribute__((address_space(4))) Args* KArgs;
    const int ph_lo = a.ph_lo, ph_hi = a.ph_hi;
    volatile LAS unsigned* xb_st = (volatile LAS unsigned*)(lds + MISC_OFF + 64);
    if (MK_LAUNCHES == 1) {
        if (threadIdx.x == 0) { xb_st[0] = 0u; xb_st[1] = 0u; (void)xb_add((unsigned*)(a.ws + WS_CTL + CTL_BAR) + XB_XCNT(xb_xcc_id()), 1u); }
        __syncthreads();
    }
#ifndef PROBE_RPT
#define PROBE_RPT (-1)
#endif
    constexpr int NVP = (PROBE_RPT >= 0) ? 2 : 0;
    for (int vp = ph_lo; vp < ph_hi + NVP; ++vp) {
        int ph = vp; bool dry = false;
        int tid = threadIdx.x; asm volatile("" : "+v"(tid));
        int G = gridDim.x, bx = blockIdx.x; asm volatile("" : "+s"(G), "+s"(bx));
        if (PROBE_RPT >= 0) {
            constexpr int P1 = PROBE_RPT, P2 = NPL + PROBE_RPT;
            if (vp <= P1) { ph = vp; dry = (vp == P1); } else if (vp <= P2 + 1) { ph = vp - 1; dry = (vp == P2 + 1); } else ph = vp - 2;
        }
        KArgs ap = (KArgs)__builtin_amdgcn_kernarg_segment_ptr(); asm volatile("" : "+s"(ap));
#define AIN(i) (ap->in[i])
        unsigned char* ws = ap->ws; float* out = ap->out;
        u64* ssq_all = (u64*)(ws + WS_CTL + CTL_SSQ);
        u64* ssqm = (u64*)(ws + WS_SSQM);
        unsigned* qctr = (unsigned*)(ws + WS_CTL);
        bf16_t* HB = (bf16_t*)(ws + WS_HB); bf16_t* MB = (bf16_t*)(ws + WS_MB); bf16_t* MEMB = (bf16_t*)(ws + WS_MEMB); bf16_t* KVB = (bf16_t*)(ws + WS_KV);
        bf16_t* ACT = (bf16_t*)(ws + WS_ACT); bf16_t* XQB = (bf16_t*)(ws + WS_XQB); bf16_t* XOB = (bf16_t*)(ws + WS_XOB);
        float* M32 = (float*)(ws + WS_M32);
        if (ph == 2 * NPL) {
            const u64* ssq = ssq_all + (size_t)8 * T; const float* fg = AIN(27);
            const int lane = tid & 63, gw = bx * 8 + (tid >> 6), nw = G * 8;
            for (int r = gw; r < T; r += nw) {
                const float rs = rstd_of(ssq[r]); const bf16_t* hr = (const bf16_t*)(ws + WS_H16) + (size_t)r * D; float* orow = out + (size_t)r * D;
#pragma unroll
                for (int i = 0; i < 8; ++i) { const int cidx = (i * 64 + lane) * 4; const u32x2 hw = *(const u32x2*)(hr + cidx); const f32x4 gg = *(const f32x4*)(fg + cidx);
                    const f32x2 a2 = unpk_f16(hw.x), b2 = unpk_f16(hw.y); f32x4 v; v[0] = a2.x; v[1] = a2.y; v[2] = b2.x; v[3] = b2.y; *(f32x4*)(orow + cidx) = v * rs * gg; }
            }
        } else {
            const int l = ph / NPL, k = ph - l * NPL;
            switch (k) {
#ifndef PH_MASK
#define PH_MASK 0xfff
#endif
            case 0: { if (!(PH_MASK & (1 << 0))) break;
                int base = 0;
                prep_job<1>(lds, AIN(3) + (size_t)l * D * 2 * DFF, D, 2 * DFF, (bf16_t*)(ws + W_FFN1_IN), 2 * DFF, AIN(2) + l * D, 1.f, base, G, bx);
                prep_job<0>(lds, AIN(4) + (size_t)l * DFF * D, DFF, D, (bf16_t*)(ws + W_FFN1_OUT), D, nullptr, 0.5f, base, G, bx);
                prep_job<2>(lds, AIN(6) + (size_t)l * D * 14360, D, 14360, (bf16_t*)(ws + W_IN), NINP, AIN(5) + l * D, 1.f, base, G, bx);
                prep_job<0>(lds, AIN(15) + (size_t)l * 1024 * D, 1024, D, (bf16_t*)(ws + W_BA), D, nullptr, 1.f, base, G, bx);
                prep_job<0>(lds, AIN(16) + (size_t)l * 1024 * D, 1024, D, (bf16_t*)(ws + W_BB), D, nullptr, 1.f, base, G, bx);
                prep_job<0>(lds, AIN(17) + (size_t)l * 1024 * D, 1024, D, (bf16_t*)(ws + W_BC), D, nullptr, 1.f, base, G, bx);
                prep_job<0>(lds, AIN(18) + (size_t)l * D * D, D, D, (bf16_t*)(ws + W_OUT), D, nullptr, 1.f, base, G, bx);
                prep_job<0>(lds, AIN(21) + (size_t)l * D * 512, D, 512, (bf16_t*)(ws + W_XQ), 512, AIN(19) + l * D, 0.08838834764831845f * LOG2E, base, G, bx);
                prep_job<0>(lds, AIN(22) + (size_t)l * D * 1024, D, 1024, (bf16_t*)(ws + W_XKV), 1024, AIN(20) + l * D, 1.f, base, G, bx);
                prep_job<0>(lds, AIN(23) + (size_t)l * 512 * D, 512, D, (bf16_t*)(ws + W_XO), D, nullptr, 1.f, base, G, bx);
                prep_job<1>(lds, AIN(25) + (size_t)l * D * 2 * DFF, D, 2 * DFF, (bf16_t*)(ws + W_FFN2_IN), 2 * DFF, AIN(24) + l * D, 1.f, base, G, bx);
                prep_job<0>(lds, AIN(26) + (size_t)l * DFF * D, DFF, D, (bf16_t*)(ws + W_FFN2_OUT), D, nullptr, 0.5f, base, G, bx);
                if (l == 0) {
                    const int gw = bx * 8 + (tid >> 6), nw = G * 8;
                    rows_to_bf16(AIN(0), HB, (bf16_t*)(ws + WS_H16), ssq_all, T, gw, nw);
                    rows_to_bf16(AIN(1), MEMB, nullptr, ssqm, MEMT, gw, nw);
                }
            } break;
            case 1: case 11: { if (!(PH_MASK & (1 << 1))) break;
                pg8::Gemm g{HB, (const bf16_t*)(ws + (k == 1 ? W_FFN1_IN : W_FFN2_IN)), T, 2 * DFF, D};
                pg8::StaticOrder S; S.init(T, 2 * DFF, G, bx);
                pg8::EpiSwiGLU E{ACT, ssq_all + (size_t)(4 * l + (k == 1 ? 0 : 3)) * T};
                pg8::gemm_phase(lds, g, S, E);
            } break;
            case 2: case 12: { if (!(PH_MASK & (1 << 2))) break;
                pg8::Gemm g{ACT, (const bf16_t*)(ws + (k == 2 ? W_FFN1_OUT : W_FFN2_OUT)), T, D, DFF};
                pg8::StaticOrder S; S.init(T, D, G, bx);
                pg8::EpiResid E{HB, (bf16_t*)(ws + WS_H16), ssq_all + (size_t)(4 * l + (k == 2 ? 1 : 4)) * T, (int)dry};
                pg8::gemm_phase(lds, g, S, E);
            } break;
            case 3: { if (!(PH_MASK & (1 << 3))) break;
                pg8::Gemm g{HB, (const bf16_t*)(ws + W_IN), T, NINP - 256, D};
                pg8::StaticOrder S; S.init(T, NINP - 256, G, bx);
                pg8::EpiWin E{ws, ssq_all + (size_t)(4 * l + 1) * T};
                pg8::gemm_phase(lds, g, S, E);
                for (int rb = bx; rb < T / 64; rb += G)
                    narrow_cols_unit(lds, rb, HB, (const bf16_t*)(ws + W_IN) + (size_t)(NINP - 256) * D, ssq_all + (size_t)(4 * l + 1) * T, AIN(11) + l * 8, (float*)(ws + WS_LOGF), (float*)(ws + WS_GA));
            } break;
            case 4: { if (!(PH_MASK & (1 << 4))) break;
                LAS int* slot = (LAS int*)(lds + MISC_OFF);
                for (;;) {
                    const int u = queue_pop(qctr + l + (dry ? 4 : 0), slot);
                    if (u >= 1024 + 512) break;
                    if (u < 1024) {
                        gla_pre_unit(lds, u >> 7, (u >> 5) & 3, u & 31, ws, AIN(12) + (size_t)l * 16 * 512, AIN(13) + l * 512);
                    } else {
                        const int s = u - 1024, g = s & 3, n = (s >> 2) & 15, b = s >> 6;
                        sgu_unit(lds, b, n, g, (const bf16_t*)(ws + Z_V), (bf16_t*)(ws + Z_U), AIN(7) + l * 1024, AIN(8) + l * 1024, AIN(9) + (size_t)l * 4 * 128 * 128, AIN(10) + l * 512, dry);
                    }
                }
            } break;
            case 5: { if (!(PH_MASK & (1 << 5))) break;
                if (bx < 32) { gla_seq_unit(lds, bx >> 2, bx & 3, ws, AIN(14) + l * 1024, dry); }
                else {
                    if (!dry) {
                        pg8::StaticOrder S; S.init(T, D, G - 32, bx - 32);
                        pg8::Gemm g{(const bf16_t*)(ws + Z_U), (const bf16_t*)(ws + W_BA), T, D, 1024}; pg8::EpiBranch E{(const bf16_t*)(ws + Z_GATES), M32, MB, (bf16_t*)(ws + WS_MA), 0}; pg8::gemm_phase(lds, g, S, E);
                    }
                    __syncthreads();
                    LAS int* slot = (LAS int*)(lds + MISC_OFF);
                    for (;;) {
                        const int q = queue_pop(qctr + 2 + l + (dry ? 4 : 0), slot);
                        if (q >= 512) break;
                        const int qb = 7 - (q >> 6), bh = q & 63, b = bh >> 3, h = bh & 7;
                        const size_t rb = (size_t)b * SEQ;
                        bf16_t* FQ = (bf16_t*)(ws + Z_FQ); const bf16_t* FK = (const bf16_t*)(ws + Z_FK); const bf16_t* FV = (const bf16_t*)(ws + Z_FV);
                        attn_unit<true>(lds, FQ + (rb + qb * 256) * 1024 + h * 128, 1024, FK + rb * 1024 + h * 128, FV + rb * 1024 + h * 128, 1024,
                                        FQ + (rb + qb * 256) * 1024 + h * 128, 1024, (qb + 1) * 4, qb * 256, (const float*)(ws + WS_LOGF) + rb * 8 + h, dry);
                    }
                }
            } break;
            case 6: { if (!(PH_MASK & (1 << 6))) break;
                pg8::StaticOrder S; S.init(T, D, G, bx);
                const bf16_t* gates = (const bf16_t*)(ws + Z_GATES);
                { pg8::Gemm g{(const bf16_t*)(ws + Z_FQ), (const bf16_t*)(ws + W_BB), T, D, 1024}; pg8::EpiBranch E{gates, M32, MB, (bf16_t*)(ws + WS_MA), 1}; pg8::gemm_phase(lds, g, S, E); }
                { pg8::Gemm g{(const bf16_t*)(ws + Z_GR), (const bf16_t*)(ws + W_BC), T, D, 1024}; pg8::EpiBranch E{gates, M32, MB, (bf16_t*)(ws + WS_MA), 2}; pg8::gemm_phase(lds, g, S, E); }
            } break;
            case 7: { if (!(PH_MASK & (1 << 7))) break;
                pg8::Gemm g{MB, (const bf16_t*)(ws + W_OUT), T, D, D};
                pg8::StaticOrder S; S.init(T, D, G, bx);
                pg8::EpiResid E{HB, (bf16_t*)(ws + WS_H16), ssq_all + (size_t)(4 * l + 2) * T, (int)dry};
                pg8::gemm_phase(lds, g, S, E);
            } break;
            case 8: { if (!(PH_MASK & (1 << 8))) break;
                { pg8::Gemm g{HB, (const bf16_t*)(ws + W_XQ), T, 512, D}; pg8::StaticOrder S; S.init(T, 512, G, bx);
                  pg8::EpiRowScale E{XQB, 512, ssq_all + (size_t)(4 * l + 2) * T}; pg8::gemm_phase(lds, g, S, E); }
                { pg8::Gemm g{MEMB, (const bf16_t*)(ws + W_XKV), MEMT, 1024, D}; pg8::StaticOrder S; S.init(MEMT, 1024, G, (bx + G - 128) % G);
                  pg8::EpiRowScale E{KVB, 1024, ssqm}; pg8::gemm_phase(lds, g, S, E); }
            } break;
            case 9: { if (!(PH_MASK & (1 << 9))) break;
                for (int u = bx; u < 256; u += G) {
                    const int qb = u & 7, h = (u >> 3) & 3, b = u >> 5;
                    const size_t rq = (size_t)b * SEQ + qb * 256, rk = (size_t)b * 256;
                    attn_unit<false>(lds, XQB + rq * 512 + h * 128, 512, KVB + rk * 1024 + h * 128, KVB + rk * 1024 + 512 + h * 128, 1024, XOB + rq * 512 + h * 128, 512, 4, 0, nullptr, false);
                }
            } break;
            case 10: { if (!(PH_MASK & (1 << 10))) break;
                pg8::Gemm g{XOB, (const bf16_t*)(ws + W_XO), T, D, 512};
                pg8::StaticOrder S; S.init(T, D, G, bx);
                pg8::EpiResid E{HB, (bf16_t*)(ws + WS_H16), ssq_all + (size_t)(4 * l + 3) * T, (int)dry};
                pg8::gemm_phase(lds, g, S, E);
            } break;
            default: break;
            }
        }
        if (vp + 1 < ph_hi + NVP) {
            if (vp == ph_lo) cg::this_grid().sync();
            else xcd_barrier((unsigned*)(ws + WS_CTL + CTL_BAR), xb_st, tid == 0, (unsigned)G);
        }
    }
}

extern "C" void kernel_launch(void* const* d_in, const int* in_sizes, int n_in, void* d_out, int out_size, void* d_ws, size_t ws_size, hipStream_t stream) {
    static int grid = 0;
    if (grid == 0) {
        if (n_in != 28 || out_size != T * D || ws_size < WS_END) { fprintf(stderr, "kernel_launch: unexpected shapes (n_in %d, out %d, ws %zu < %zu)\n", n_in, out_size, ws_size, (size_t)WS_END); grid = -1; return; }
        int dev = 0, cus = 0, per_cu = 0;
        hipGetDevice(&dev); hipDeviceGetAttribute(&cus, hipDeviceAttributeMultiprocessorCount, dev);
        if (hipFuncSetAttribute((const void*)fwd_kernel, hipFuncAttributeMaxDynamicSharedMemorySize, LDS_BYTES) != hipSuccess) { fprintf(stderr, "kernel_launch: hipFuncSetAttribute failed\n"); grid = -1; return; }
        if (hipOccupancyMaxActiveBlocksPerMultiprocessor(&per_cu, (const void*)fwd_kernel, NTHREADS, LDS_BYTES) != hipSuccess || per_cu < 1) { fprintf(stderr, "kernel_launch: occupancy query says %d\n", per_cu); per_cu = 1; }
        (void)hipGetLastError();
        grid = cus * 1;
    }
    if (grid < 0) return;
    (void)hipMemsetAsync((char*)d_ws + WS_CTL, 0, CTL_BYTES, stream);
    Args a{};
    for (int i = 0; i < 28; ++i) a.in[i] = (const float*)d_in[i];
    a.out = (float*)d_out; a.ws = (unsigned char*)d_ws;
#if MK_LAUNCHES == 1
    a.ph_lo = 0; a.ph_hi = N_PHASES;
    void* args[] = {&a};
    hipError_t e = hipLaunchCooperativeKernel((const void*)fwd_kernel, dim3(grid), dim3(NTHREADS), args, LDS_BYTES, stream);
    if (e != hipSuccess) fprintf(stderr, "cooperative launch failed: %s (grid %d)\n", hipGetErrorString(e), grid);
#else
    for (int p = 0; p < N_PHASES; ++p) {
        a.ph_lo = p; a.ph_hi = p + 1;
        hipLaunchKernelGGL(fwd_kernel, dim3(grid), dim3(NTHREADS), LDS_BYTES, stream, a);
    }
#endif
}
```
